# Optimizing an MI355X kernel written in HIP

```python
import math
import jax
import jax.numpy as jnp
from jax import lax
import numpy as np

D_MODEL = 1024
BATCH = 2
SEQ = 8192
DEPTH = 2

GRID_W = 64
HEAD_DIM = 64
N_HEADS_TOTAL = D_MODEL // HEAD_DIM
GROUP_HEADS = N_HEADS_TOTAL // 4
GROUP_KV_HEADS = GROUP_HEADS // 2
GQA_GROUP = GROUP_HEADS // GROUP_KV_HEADS
MIX_WIDTH = 4 * GROUP_HEADS * HEAD_DIM
ROPE_THETA = 10000.0
NORM_EPS = 1e-6
Q_BLOCK = 128
NEG_INF = -1e30

NA_WIN_ROWS = 8
NA_WIN_COLS = 16

MLA_Q_RANK = D_MODEL // 4
MLA_KV_RANK = D_MODEL // 8
MLA_NOPE = HEAD_DIM
MLA_ROPE = HEAD_DIM // 2
MLA_V = HEAD_DIM

SW_WINDOW = 128

D_FF = 2816
CONV_W = 3

SPLIT_SIZES = (
    GROUP_HEADS * HEAD_DIM, GROUP_HEADS * HEAD_DIM, GROUP_HEADS * HEAD_DIM,
    MLA_Q_RANK, MLA_KV_RANK, MLA_ROPE,
    GROUP_HEADS * HEAD_DIM, GROUP_KV_HEADS * HEAD_DIM, GROUP_KV_HEADS * HEAD_DIM,
    GROUP_HEADS * HEAD_DIM, GROUP_KV_HEADS * HEAD_DIM, GROUP_KV_HEADS * HEAD_DIM,
)
IN_COLS = sum(SPLIT_SIZES)

kernel_name = 'hybrid_parallel_head_group_encoder'


def rms_norm(x, gain):
    xf = x.astype(jnp.float32)
    y = xf * lax.rsqrt(jnp.mean(xf * xf, axis=-1, keepdims=True) + NORM_EPS) * gain.astype(jnp.float32)
    return y.astype(x.dtype)


def rope_angles(pos, dim):
    inv = ROPE_THETA ** (-jnp.arange(0, dim, 2, dtype=jnp.float32) / dim)
    return pos.astype(jnp.float32)[:, None] * inv[None, :]


def apply_rope(x, ang):
    cos = jnp.cos(ang)[None, :, None, :]
    sin = jnp.sin(ang)[None, :, None, :]
    x1, x2 = jnp.split(x.astype(jnp.float32), 2, axis=-1)
    out = jnp.concatenate([x1 * cos - x2 * sin, x2 * cos + x1 * sin], axis=-1)
    return out.astype(x.dtype)


def axial_rope(x, ang_row, ang_col):
    half = x.shape[-1] // 2
    return jnp.concatenate([apply_rope(x[..., :half], ang_row), apply_rope(x[..., half:], ang_col)], axis=-1)


def split_columns(z):
    points = []
    acc = 0
    for n in SPLIT_SIZES[:-1]:
        acc += n
        points.append(acc)
    return jnp.split(z, points, axis=-1)


def dense_attention_blocked(q, k, v, scale):
    b, s, hkv, g, dq = q.shape
    nb = s // Q_BLOCK
    qb = q.reshape(b, nb, Q_BLOCK, hkv, g, dq).transpose(1, 0, 2, 3, 4, 5)

    def one_block(q_blk):
        sc = jnp.einsum('bqhgd,bkhd->bhgqk', q_blk, k).astype(jnp.float32) * scale
        p = jax.nn.softmax(sc, axis=-1).astype(v.dtype)
        return jnp.einsum('bhgqk,bkhd->bqhgd', p, v)

    out = lax.map(one_block, qb)
    return out.transpose(1, 0, 2, 3, 4, 5).reshape(b, s, hkv, g, v.shape[-1])


def sliding_window_sink_attention(q, k, v, sink, scale):
    b, s, hkv, g, d = q.shape
    nb = s // Q_BLOCK
    pad = ((0, 0), (Q_BLOCK, Q_BLOCK), (0, 0), (0, 0))
    kp = jnp.pad(k, pad).reshape(b, nb + 2, Q_BLOCK, hkv, d)
    vp = jnp.pad(v, pad).reshape(b, nb + 2, Q_BLOCK, hkv, d)
    kb = jnp.concatenate([kp[:, :-2], kp[:, 1:-1], kp[:, 2:]], axis=2)
    vb = jnp.concatenate([vp[:, :-2], vp[:, 1:-1], vp[:, 2:]], axis=2)
    qb = q.reshape(b, nb, Q_BLOCK, hkv, g, d)
    sc = jnp.einsum('bnqhgd,bnkhd->bnhgqk', qb, kb).astype(jnp.float32) * scale
    blk = jnp.arange(nb)[:, None] * Q_BLOCK
    qpos = blk + jnp.arange(Q_BLOCK)[None, :]
    kpos = blk - Q_BLOCK + jnp.arange(3 * Q_BLOCK)[None, :]
    valid = (jnp.abs(qpos[:, :, None] - kpos[:, None, :]) <= SW_WINDOW) & ((kpos >= 0) & (kpos < s))[:, None, :]
    sc = jnp.where(valid[None, :, None, None], sc, NEG_INF)
    sink_l = jnp.broadcast_to(sink.reshape(hkv, g).astype(jnp.float32)[None, None, :, :, None, None],
                              sc.shape[:-1] + (1,))
    p = jax.nn.softmax(jnp.concatenate([sc, sink_l], axis=-1), axis=-1)[..., :-1]
    out = jnp.einsum('bnhgqk,bnkhd->bnqhgd', p.astype(v.dtype), vb)
    return out.reshape(b, s, hkv, g, d)


def neighbourhood_attention_2d(q, k, v, rpb):
    b, s, h, d = q.shape
    rows = s // GRID_W
    kr = min(NA_WIN_ROWS, rows)
    kc = NA_WIN_COLS
    qg = q.reshape(b, rows, GRID_W, h, d)
    kg = k.reshape(b, rows, GRID_W, h, d)
    vg = v.reshape(b, rows, GRID_W, h, d)
    col = jnp.arange(GRID_W)
    col_start = jnp.clip(col - kc // 2, 0, GRID_W - kc)
    col_idx = col_start[:, None] + jnp.arange(kc)[None, :]
    col_off = col_idx - col[:, None] + (NA_WIN_COLS - 1)
    row_ids = jnp.arange(rows)
    row_start = jnp.clip(row_ids - kr // 2, 0, rows - kr)
    scale = HEAD_DIM ** -0.5

    def one_row(args):
        r, rs = args
        q_r = lax.dynamic_index_in_dim(qg, r, axis=1, keepdims=False)
        k_band = lax.dynamic_slice_in_dim(kg, rs, kr, axis=1)
        v_band = lax.dynamic_slice_in_dim(vg, rs, kr, axis=1)
        k_nb = k_band[:, :, col_idx]
        v_nb = v_band[:, :, col_idx]
        row_off = rs + jnp.arange(kr) - r + (NA_WIN_ROWS - 1)
        bias = rpb[:, row_off[:, None, None], col_off[None, :, :]]
        sc = jnp.einsum('bchd,bacwhd->bhcaw', q_r, k_nb).astype(jnp.float32) * scale
        sc = sc + bias.transpose(0, 2, 1, 3)[None].astype(jnp.float32)
        p = jax.nn.softmax(sc.reshape(b, h, GRID_W, kr * kc), axis=-1)
        p = p.reshape(b, h, GRID_W, kr, kc).astype(v.dtype)
        return jnp.einsum('bhcaw,bacwhd->bchd', p, v_nb)

    out = lax.map(one_row, (row_ids, row_start))
    return out.transpose(1, 0, 2, 3, 4).reshape(b, s, h, d)


def conv_gated_mlp(h, w_up, conv_w, conv_b, w_down):
    u = h @ w_up
    s = u.shape[1]
    half = CONV_W // 2
    up = jnp.pad(u, ((0, 0), (half, half), (0, 0)))
    c = conv_b
    for i in range(CONV_W):
        c = c + up[:, i:i + s] * conv_w[i]
    gate, val = jnp.split(c, 2, axis=-1)
    return (jax.nn.gelu(gate, approximate=True) * val) @ w_down


def setup_inputs(seed: int = 0) -> dict:
    key = jax.random.key(seed)
    ks = jax.random.split(key, 20)
    f32 = jnp.float32

    def dense(k, shape, fan_in):
        return jax.random.normal(k, shape, f32) * fan_in ** -0.5

    def gain(k, n):
        return 1.0 + 0.05 * jax.random.normal(k, (DEPTH, n), f32)

    return {
        'x': jax.random.normal(ks[0], (BATCH, SEQ, D_MODEL), f32),
        'mix_pre_gain': gain(ks[1], D_MODEL),
        'w_in': dense(ks[2], (DEPTH, D_MODEL, IN_COLS), D_MODEL),
        'na_rpb': 0.1 * jax.random.normal(ks[3], (DEPTH, GROUP_HEADS, 2 * NA_WIN_ROWS - 1, 2 * NA_WIN_COLS - 1), f32),
        'mla_q_gain': gain(ks[4], MLA_Q_RANK),
        'mla_w_uq': dense(ks[5], (DEPTH, MLA_Q_RANK, GROUP_HEADS * (MLA_NOPE + MLA_ROPE)), MLA_Q_RANK),
        'mla_kv_gain': gain(ks[6], MLA_KV_RANK),
        'mla_w_ukv': dense(ks[7], (DEPTH, MLA_KV_RANK, GROUP_HEADS * (MLA_NOPE + MLA_V)), MLA_KV_RANK),
        'ax_q_gain': gain(ks[8], HEAD_DIM),
        'ax_k_gain': gain(ks[9], HEAD_DIM),
        'sw_sink': 0.5 * jax.random.normal(ks[10], (DEPTH, GROUP_HEADS), f32),
        'w_out': dense(ks[11], (DEPTH, MIX_WIDTH, D_MODEL), MIX_WIDTH),
        'mix_post_gain': gain(ks[12], D_MODEL),
        'ffn_pre_gain': gain(ks[13], D_MODEL),
        'w_up': dense(ks[14], (DEPTH, D_MODEL, 2 * D_FF), D_MODEL),
        'conv_w': dense(ks[15], (DEPTH, CONV_W, 2 * D_FF), CONV_W),
        'conv_b': 0.01 * jax.random.normal(ks[16], (DEPTH, 2 * D_FF), f32),
        'w_down': dense(ks[17], (DEPTH, D_FF, D_MODEL), D_FF),
        'ffn_post_gain': gain(ks[18], D_MODEL),
    }


def reference(x, mix_pre_gain, w_in, na_rpb, mla_q_gain, mla_w_uq, mla_kv_gain, mla_w_ukv,
              ax_q_gain, ax_k_gain, sw_sink, w_out, mix_post_gain, ffn_pre_gain, w_up,
              conv_w, conv_b, w_down, ffn_post_gain):
    b, s, _ = x.shape
    t = jnp.arange(s)
    ang_full = rope_angles(t, HEAD_DIM)
    ang_mla = rope_angles(t, MLA_ROPE)
    ang_row = rope_angles(t // GRID_W, HEAD_DIM // 2)
    ang_col = rope_angles(t % GRID_W, HEAD_DIM // 2)

    def heads(z, n):
        return z.reshape(b, s, n, -1)

    for l in range(DEPTH):
        h = rms_norm(x, mix_pre_gain[l])
        (a_q, a_k, a_v, b_cq, b_ckv, b_kr,
         c_q, c_k, c_v, d_q, d_k, d_v) = split_columns(h @ w_in[l])

        o_a = neighbourhood_attention_2d(heads(a_q, GROUP_HEADS), heads(a_k, GROUP_HEADS),
                                         heads(a_v, GROUP_HEADS), na_rpb[l])

        q_b = (rms_norm(b_cq, mla_q_gain[l]) @ mla_w_uq[l]).reshape(b, s, GROUP_HEADS, MLA_NOPE + MLA_ROPE)
        q_nope, q_pe = jnp.split(q_b, [MLA_NOPE], axis=-1)
        q_b = jnp.concatenate([q_nope, apply_rope(q_pe, ang_mla)], axis=-1)
        kv_b = (rms_norm(b_ckv, mla_kv_gain[l]) @ mla_w_ukv[l]).reshape(b, s, GROUP_HEADS, MLA_NOPE + MLA_V)
        k_nope, v_b = jnp.split(kv_b, [MLA_NOPE], axis=-1)
        k_pe = apply_rope(b_kr.reshape(b, s, 1, MLA_ROPE), ang_mla)
        k_b = jnp.concatenate([k_nope, jnp.broadcast_to(k_pe, (b, s, GROUP_HEADS, MLA_ROPE))], axis=-1)
        o_b = dense_attention_blocked(q_b[:, :, :, None, :], k_b, v_b, (MLA_NOPE + MLA_ROPE) ** -0.5)

        q_c = axial_rope(rms_norm(heads(c_q, GROUP_HEADS), ax_q_gain[l]), ang_row, ang_col)
        k_c = axial_rope(rms_norm(heads(c_k, GROUP_KV_HEADS), ax_k_gain[l]), ang_row, ang_col)
        o_c = dense_attention_blocked(q_c.reshape(b, s, GROUP_KV_HEADS, GQA_GROUP, HEAD_DIM), k_c,
                                      heads(c_v, GROUP_KV_HEADS), HEAD_DIM ** -0.5)

        q_d = apply_rope(heads(d_q, GROUP_HEADS), ang_full).reshape(b, s, GROUP_KV_HEADS, GQA_GROUP, HEAD_DIM)
        k_d = apply_rope(heads(d_k, GROUP_KV_HEADS), ang_full)
        o_d = sliding_window_sink_attention(q_d, k_d, heads(d_v, GROUP_KV_HEADS), sw_sink[l], HEAD_DIM ** -0.5)

        mixed = jnp.concatenate([o_a.reshape(b, s, -1), o_b.reshape(b, s, -1),
                                 o_c.reshape(b, s, -1), o_d.reshape(b, s, -1)], axis=-1) @ w_out[l]
        x = x + rms_norm(mixed, mix_post_gain[l])

        h = rms_norm(x, ffn_pre_gain[l])
        y = conv_gated_mlp(h, w_up[l], conv_w[l], conv_b[l], w_down[l])
        x = x + rms_norm(y, ffn_post_gain[l])
    return x
```

```cpp
#include <hip/hip_runtime.h>
#include <hip/hip_cooperative_groups.h>
#include <cstdio>
#include <cstdint>
namespace pg8 {
#define PG8_LAS __attribute__((address_space(3)))
typedef unsigned short bf16_t;
typedef short bf16x8 __attribute__((ext_vector_type(8)));
typedef float f32x4 __attribute__((ext_vector_type(4)));
typedef unsigned u32x4 __attribute__((ext_vector_type(4)));
constexpr int BM = 256, BK = 64, HALF = 128, HTB = HALF * BK * 2  , STAGE_BYTES = 8 * HTB, NXCD = 8, WGM = 8;

__host__ __device__ __forceinline__ int lds_byte(int r, int c) { const int st = (r >> 4) * 2 + (c >> 5), rr = r & 15, cc = c & 31, ob = rr * 64 + cc * 2; return st * 1024 + (ob ^ (((ob >> 9) & 1) << 5)); }
__host__ __device__ __forceinline__ void stage_rc(int b, int& R, int& C) { const int st = b / 1024, sb = b % 1024, swz = sb ^ (((sb >> 9) & 1) << 5); R = (st >> 1) * 16 + swz / 64; C = (st & 1) * 32 + (swz % 64) / 2; }
__host__ __device__ __forceinline__ int perm32(int rho) { const int n = rho >> 4, i = rho & 15; return 8 * (i >> 2) + 4 * n + (i & 3); }

struct Unit { int pm, pn; };
struct Gemm { const bf16_t* A; const bf16_t* Bt; int M, N, K, lda, ldb; };

struct StaticOrder {
    int nM, nN, nwg, G, c;
    __host__ __device__ void init(int M, int N, int G_, int c_) { nM = M / BM; nN = N / BM; nwg = nM * nN; G = G_; c = c_; }
    __host__ __device__ bool next(int i, Unit& u) const {
        const long L = (long)i * G + c; if (L >= nwg) return false;
        int wgid = (int)L; { const int q = nwg / NXCD, r = nwg % NXCD, xcd = wgid % NXCD, off = wgid / NXCD; wgid = (xcd < r ? xcd * (q + 1) : r * (q + 1) + (xcd - r) * q) + off; }
        const int nig = WGM * nN, gid = wgid / nig, fm = gid * WGM, gsz = (nM - fm) < WGM ? (nM - fm) : WGM;
        u.pm = fm + ((wgid % nig) % gsz); u.pn = (wgid % nig) / gsz; return true;
    }
    __device__ __forceinline__ void a_ready(const Unit&) const {}
    __device__ __forceinline__ void done(const Unit&) const {}
};

__device__ __forceinline__ unsigned cvt_pk_bf16(float lo, float hi) { unsigned r; asm volatile("v_cvt_pk_bf16_f32 %0, %1, %2" : "=v"(r) : "v"(lo), "v"(hi)); return r; }
typedef float f32x2 __attribute__((ext_vector_type(2)));
__device__ __forceinline__ f32x2 gelu_pk(f32x2 v) {
    const f32x2 av = __builtin_elementwise_abs(v), d = av * 0.2316418882f + 1.0f;
    f32x2 t; t.x = __builtin_amdgcn_rcpf(d.x); t.y = __builtin_amdgcn_rcpf(d.y);
    f32x2 q = t * 0.5307027145f + (-0.7265760135f); q = q * t + 0.7107068705f; q = q * t + (-0.142248368f); q = q * t + 0.127414796f; q = q * t;
    const f32x2 s = (v * v) * (-0.72134752044f);
    f32x2 e; e.x = __builtin_amdgcn_exp2f(s.x); e.y = __builtin_amdgcn_exp2f(s.y);
    const f32x2 m = v * (q * e), r = v - m;
    f32x2 o; o.x = v.x < 0.f ? m.x : r.x; o.y = v.y < 0.f ? m.y : r.y; return o;
}

template <int ACT  > struct EpiBf16 {
    static constexpr bool PERM = true, AFTER_DRAIN = false; static_assert(ACT == 0 || ACT == 1, "EpiBf16: ACT is 0 (none) or 1 (gelu_pk)");
    bf16_t* O; int ldc; const float* bias; int split_cols; size_t split_stride; float scale0;
    __device__ __forceinline__ void operator()(const f32x4 (&acc)[2][2][4][2], const Unit& u, int wr, int wc, int fr, int fq) const {
        const int row0 = u.pm * BM + wr * 64 + fr; int colt = u.pn * BM; bf16_t* base = O;
        float sc = 1.f; if (split_cols) { const int t = colt / split_cols; base += (size_t)t * split_stride; colt -= t * split_cols; if (t == 0) sc = scale0; }
        const int col0 = colt + wc * 32 + 8 * fq, bcol0 = u.pn * BM + wc * 32 + 8 * fq;
        f32x4 bv[2][2];
#pragma unroll
        for (int bj = 0; bj < 2; ++bj)
#pragma unroll
            for (int n = 0; n < 2; ++n) bv[bj][n] = bias ? *(const f32x4*)(bias + bcol0 + bj * HALF + 4 * n) : (f32x4){0.f, 0.f, 0.f, 0.f};
#pragma unroll
        for (int ai = 0; ai < 2; ++ai)
#pragma unroll
            for (int m = 0; m < 4; ++m) { bf16_t* rowp = base + (size_t)(row0 + ai * HALF + m * 16) * ldc + col0;
#pragma unroll
                for (int bj = 0; bj < 2; ++bj) { f32x4 v0 = acc[ai][bj][m][0] + bv[bj][0], v1 = acc[ai][bj][m][1] + bv[bj][1];
                    if (ACT == 1) { f32x2 a = gelu_pk((f32x2){v0[0], v0[1]}), b = gelu_pk((f32x2){v0[2], v0[3]}), c = gelu_pk((f32x2){v1[0], v1[1]}), d = gelu_pk((f32x2){v1[2], v1[3]});
                        v0 = (f32x4){a.x, a.y, b.x, b.y}; v1 = (f32x4){c.x, c.y, d.x, d.y}; }
                    v0 = v0 * sc; v1 = v1 * sc; u32x4 w; w.x = cvt_pk_bf16(v0[0], v0[1]); w.y = cvt_pk_bf16(v0[2], v0[3]); w.z = cvt_pk_bf16(v1[0], v1[1]); w.w = cvt_pk_bf16(v1[2], v1[3]);
                    *(u32x4*)(rowp + bj * HALF) = w; } }
    }
};

struct PanelStats {
    unsigned* xbuf;
    unsigned* cnt;
    unsigned* tmo;
    int ntn; float eps;
    unsigned code;
    __device__ __forceinline__ bool run(const f32x4 (&v)[2][2][4][2], const Unit& u, int wr, int wc, int fr, int fq, PG8_LAS unsigned char* lds, int wid, int lane) const {
        typedef float f32x2v __attribute__((ext_vector_type(2)));
        PG8_LAS f32x2v* P = (PG8_LAS f32x2v*)lds;
        PG8_LAS f32x2v* S = (PG8_LAS f32x2v*)(lds + 8192);
        PG8_LAS unsigned* flag = (PG8_LAS unsigned*)(lds + 8192 + 2048);
#pragma unroll
        for (int ai = 0; ai < 2; ++ai)
#pragma unroll
            for (int m = 0; m < 4; ++m) {
                float s = 0.f;
#pragma unroll
                for (int bj = 0; bj < 2; ++bj)
#pragma unroll
                    for (int n = 0; n < 2; ++n) { const f32x4 x = v[ai][bj][m][n]; s += (x[0] + x[1]) + (x[2] + x[3]); }
                s += __shfl_xor(s, 16); s += __shfl_xor(s, 32);
                const float mw = s * (1.0f / 64.0f); float q = 0.f;
#pragma unroll
                for (int bj = 0; bj < 2; ++bj)
#pragma unroll
                    for (int n = 0; n < 2; ++n) { const f32x4 d = v[ai][bj][m][n] - mw; q += (d[0] * d[0] + d[1] * d[1]) + (d[2] * d[2] + d[3] * d[3]); }
                q += __shfl_xor(q, 16); q += __shfl_xor(q, 32);
                if (fq == 0) P[(ai * HALF + wr * 64 + m * 16 + fr) * 4 + wc] = (f32x2v){mw, q};
            }
        asm volatile("s_waitcnt lgkmcnt(0)" ::: "memory"); __builtin_amdgcn_s_barrier(); asm volatile("" ::: "memory");
#if defined(BROKEN_EXCHANGE_NO_WAIT)
#warning BROKEN CONTROL BUILD: the row-statistics exchange does not wait; results are wrong by design
        if (blockIdx.x >= 64) { const long long t0_ = clock64(); while (clock64() - t0_ < 60000) __builtin_amdgcn_s_sleep(8); }
#endif
        const int row = wid * 32 + (lane & 31);
        if (lane < 32) {
            const f32x2v a = P[row * 4 + 0], b = P[row * 4 + 1], c = P[row * 4 + 2], d = P[row * 4 + 3];
            const float mt = (a.x + b.x + c.x + d.x) * 0.25f;
            const float da = a.x - mt, db = b.x - mt, dc = c.x - mt, dd = d.x - mt;
            const float m2 = (a.y + b.y) + (c.y + d.y) + 64.0f * ((da * da + db * db) + (dc * dc + dd * dd));
            unsigned long long* slot = (unsigned long long*)xbuf + ((size_t)(u.pm * BM + row) * 4 + u.pn);
            __hip_atomic_store(slot, ((unsigned long long)__float_as_uint(m2) << 32) | __float_as_uint(mt), __ATOMIC_RELAXED, __HIP_MEMORY_SCOPE_AGENT);
        }
        asm volatile("s_waitcnt vmcnt(0)" ::: "memory");
        if (lane == 0) __hip_atomic_fetch_add(cnt + 64 * u.pm, 1u, __ATOMIC_RELAXED, __HIP_MEMORY_SCOPE_AGENT);
        if (wid == 0) {
            bool dead = false; const unsigned long long t0 = __builtin_amdgcn_s_memrealtime(); const unsigned want = 8u * (unsigned)ntn;
            for (;;) {
#if defined(BROKEN_EXCHANGE_NO_WAIT)
                break;
#endif
                if ((unsigned)__builtin_amdgcn_readfirstlane(__hip_atomic_load(cnt + 64 * u.pm, __ATOMIC_RELAXED, __HIP_MEMORY_SCOPE_AGENT)) >= want) break;
                if (__builtin_amdgcn_s_memrealtime() - t0 > 2000000ull) {
                    if (lane == 0) { unsigned expect = 0u; __hip_atomic_compare_exchange_strong(tmo + 1, &expect, code | (unsigned)(u.pm & 0xff), __ATOMIC_RELAXED, __ATOMIC_RELAXED, __HIP_MEMORY_SCOPE_AGENT);
                                     __hip_atomic_store(tmo, 1u, __ATOMIC_RELAXED, __HIP_MEMORY_SCOPE_AGENT); }
                    dead = true; break; }
                __builtin_amdgcn_s_sleep(2);
            }
            __builtin_amdgcn_fence(__ATOMIC_ACQUIRE, "agent");
            if (lane == 0) flag[0] = dead ? 1u : 0u;
        }
        asm volatile("s_waitcnt vmcnt(0) lgkmcnt(0)" ::: "memory"); __builtin_amdgcn_s_barrier(); asm volatile("" ::: "memory");
        const bool bad = flag[0] != 0u;
        if (lane < 32) {
            const unsigned long long* slot = (const unsigned long long*)xbuf + (size_t)(u.pm * BM + row) * 4; float mt[4], m2[4]; float ms = 0.f;
#pragma unroll
            for (int t = 0; t < 4; ++t) { if (t < ntn) { const unsigned long long w = __hip_atomic_load(slot + t, __ATOMIC_RELAXED, __HIP_MEMORY_SCOPE_AGENT); mt[t] = __uint_as_float((unsigned)w); m2[t] = __uint_as_float((unsigned)(w >> 32)); } else { mt[t] = 0.f; m2[t] = 0.f; } ms += mt[t]; }
            const float mean = ms / (float)ntn; float q = 0.f;
#pragma unroll
            for (int t = 0; t < 4; ++t) if (t < ntn) { const float dm = mt[t] - mean; q += m2[t] + 256.0f * dm * dm; }
            S[row] = (f32x2v){mean, 1.0f / sqrtf(q / (256.0f * (float)ntn) + eps)};
        }
        asm volatile("s_waitcnt lgkmcnt(0)" ::: "memory"); __builtin_amdgcn_s_barrier(); asm volatile("" ::: "memory");
        return bad;
    }
};
struct EpiLnRes {
    static constexpr bool PERM = false, AFTER_DRAIN = true;
    const float* base; float* out; int ldc; const float* bias; PanelStats st; unsigned poison;
    __device__ __forceinline__ void fused(f32x4 (&acc)[2][2][4][2], const Unit& u, int wr, int wc, int fr, int fq, PG8_LAS unsigned char* lds, int wid, int lane) const {
        typedef float f32x2v __attribute__((ext_vector_type(2)));
        const PG8_LAS f32x2v* S = (const PG8_LAS f32x2v*)(lds + 8192);
        const int col0 = u.pn * BM + wc * 32 + 4 * fq;
#pragma unroll
        for (int bj = 0; bj < 2; ++bj)
#pragma unroll
            for (int n = 0; n < 2; ++n) { const f32x4 bv = bias ? *(const f32x4*)(bias + col0 + bj * HALF + n * 16) : (f32x4){0.f, 0.f, 0.f, 0.f};
#pragma unroll
                for (int ai = 0; ai < 2; ++ai)
#pragma unroll
                    for (int m = 0; m < 4; ++m) acc[ai][bj][m][n] += bv; }
        f32x4 pre[4][2][2];
#pragma unroll
        for (int m = 0; m < 4; ++m) { const size_t off = (size_t)(u.pm * BM + wr * 64 + m * 16 + fr) * ldc + col0;
#pragma unroll
            for (int bj = 0; bj < 2; ++bj)
#pragma unroll
                for (int n = 0; n < 2; ++n) pre[m][bj][n] = *(const f32x4*)(base + off + bj * HALF + n * 16); }
        const bool bad = st.run(acc, u, wr, wc, fr, fq, lds, wid, lane) || poison != 0u;
        const float qnan = __builtin_nanf("");
#pragma unroll
        for (int ai = 0; ai < 2; ++ai)
#pragma unroll
            for (int m = 0; m < 4; ++m) { const int r = ai * HALF + wr * 64 + m * 16 + fr; const f32x2v sr = S[r]; const size_t off = (size_t)(u.pm * BM + r) * ldc + col0;
#pragma unroll
                for (int bj = 0; bj < 2; ++bj)
#pragma unroll
                    for (int n = 0; n < 2; ++n) { const f32x4 bs = ai == 0 ? pre[m][bj][n] : *(const f32x4*)(base + off + bj * HALF + n * 16); f32x4 o = bs + (acc[ai][bj][m][n] - sr.x) * sr.y;
                        if (bad) o = (f32x4){qnan, qnan, qnan, qnan}; *(f32x4*)(out + off + bj * HALF + n * 16) = o; }
                if (m & 1) asm volatile("" ::: "memory"); }
    }
};
struct EpiLnResLn {
    static constexpr bool PERM = false, AFTER_DRAIN = true;
    const float* base; float* out; bf16_t* xn; int ldc; const float* bias; PanelStats st1, st2; unsigned poison;
    __device__ __forceinline__ void fused(f32x4 (&acc)[2][2][4][2], const Unit& u, int wr, int wc, int fr, int fq, PG8_LAS unsigned char* lds, int wid, int lane) const {
        typedef float f32x2v __attribute__((ext_vector_type(2))); typedef unsigned u32x2v __attribute__((ext_vector_type(2)));
        const PG8_LAS f32x2v* S = (const PG8_LAS f32x2v*)(lds + 8192);
        const int col0 = u.pn * BM + wc * 32 + 4 * fq;
#pragma unroll
        for (int bj = 0; bj < 2; ++bj)
#pragma unroll
            for (int n = 0; n < 2; ++n) { const f32x4 bv = bias ? *(const f32x4*)(bias + col0 + bj * HALF + n * 16) : (f32x4){0.f, 0.f, 0.f, 0.f};
#pragma unroll
                for (int ai = 0; ai < 2; ++ai)
#pragma unroll
                    for (int m = 0; m < 4; ++m) acc[ai][bj][m][n] += bv; }
        bool bad = st1.run(acc, u, wr, wc, fr, fq, lds, wid, lane) || poison != 0u;
        const float qnan = __builtin_nanf("");
#pragma unroll
        for (int ai = 0; ai < 2; ++ai)
#pragma unroll
            for (int m = 0; m < 4; ++m) { const int r = ai * HALF + wr * 64 + m * 16 + fr; const f32x2v sr = S[r]; const size_t off = (size_t)(u.pm * BM + r) * ldc + col0;
#pragma unroll
                for (int bj = 0; bj < 2; ++bj)
#pragma unroll
                    for (int n = 0; n < 2; ++n) { const f32x4 bs = *(const f32x4*)(base + off + bj * HALF + n * 16); acc[ai][bj][m][n] = bs + (acc[ai][bj][m][n] - sr.x) * sr.y; }
                asm volatile("" : "+v"(acc[ai][0][m][0]), "+v"(acc[ai][0][m][1]), "+v"(acc[ai][1][m][0]), "+v"(acc[ai][1][m][1]));
                if (m & 1) asm volatile("" ::: "memory"); }
        const bool bad1 = bad;
        bad = st2.run(acc, u, wr, wc, fr, fq, lds, wid, lane) || bad;
#pragma unroll
        for (int ai = 0; ai < 2; ++ai)
#pragma unroll
            for (int m = 0; m < 4; ++m) { const int r = ai * HALF + wr * 64 + m * 16 + fr; const f32x2v sr = S[r]; const size_t off = (size_t)(u.pm * BM + r) * ldc + col0;
#pragma unroll
                for (int bj = 0; bj < 2; ++bj)
#pragma unroll
                    for (int n = 0; n < 2; ++n) { const f32x4 x1 = acc[ai][bj][m][n]; *(f32x4*)(out + off + bj * HALF + n * 16) = bad1 ? (f32x4){qnan, qnan, qnan, qnan} : x1;
                        const f32x4 o = (x1 - sr.x) * sr.y; u32x2v w; w.x = cvt_pk_bf16(o[0], o[1]); w.y = cvt_pk_bf16(o[2], o[3]);
                        if (bad) { w.x = 0x7fc07fc0u; w.y = 0x7fc07fc0u; } *(u32x2v*)(xn + off + bj * HALF + n * 16) = w; }
                asm volatile("" ::: "memory"); }
    }
};

template <class Epi, class Sched, bool ALIGN_EPI = false, bool SP2 = false>
__device__ __forceinline__ void gemm_phase(PG8_LAS unsigned char* lds, const Gemm g, const Sched& S, const Epi& E) {
    int tid_ = threadIdx.x; asm volatile("" : "+v"(tid_));
    const int tid = tid_, wid = __builtin_amdgcn_readfirstlane(tid >> 6), lane = tid & 63, wr = wid >> 2, wc = wid & 3, fr = lane & 15, fq = lane >> 4;
    int K_ = g.K, lda_ = g.lda, ldb_ = g.ldb; asm volatile("" : "+s"(K_), "+s"(lda_), "+s"(ldb_));
    const int K = K_, nt = K / BK;
    unsigned voffA[2], voffB[2];
#pragma unroll
    for (int i = 0; i < 2; ++i) { int R, C; stage_rc(tid * 16 + i * 8192, R, C); const int Rb = Epi::PERM ? ((R & ~31) + perm32(R & 31)) : R;
        voffA[i] = (unsigned)(R * lda_ + C) * 2u; voffB[i] = (unsigned)(Rb * ldb_ + C) * 2u; }
    const size_t kstep = (size_t)(BK * 2);
    const size_t hstepA = (size_t)HALF * lda_ * 2, hstepB = (size_t)HALF * ldb_ * 2;
    const size_t tstepA = 2 * hstepA, tstepB = 2 * hstepB;
    const unsigned ldsw = (unsigned)wid * 1024u;
    const int aoff = lds_byte(wr * 64 + fr, fq * 8), boff = lds_byte(wc * 32 + fr, fq * 8);
#define PG8_SA(b, h) (((b) * 2 + (h)) * HTB)
#define PG8_SB(b, h) ((4 + (b) * 2 + (h)) * HTB)
#define PG8_STAGE(bufoff, gbase, voff) do { _Pragma("unroll") for (int _i = 0; _i < 2; ++_i) \
        __builtin_amdgcn_global_load_lds((const unsigned*)((const char*)(gbase) + (voff)[_i]), (PG8_LAS unsigned*)(lds + (bufoff) + ldsw + _i * 8192), 16, 0, 0); } while (0)
#define PG8_LDA(dst, b, h) do { _Pragma("unroll") for (int m = 0; m < 4; ++m) _Pragma("unroll") for (int k = 0; k < 2; ++k) dst[m][k] = *(const PG8_LAS bf16x8*)(lds + PG8_SA(b, h) + aoff + m * 2048 + k * 1024); } while (0)
#define PG8_LDB(dst, b, h) do { _Pragma("unroll") for (int n = 0; n < 2; ++n) _Pragma("unroll") for (int k = 0; k < 2; ++k) dst[n][k] = *(const PG8_LAS bf16x8*)(lds + PG8_SB(b, h) + boff + n * 2048 + k * 1024); } while (0)
#define PG8_MMA(ai, bj, At, Bt) do { __builtin_amdgcn_s_setprio(1); _Pragma("unroll") for (int m = 0; m < 4; ++m) _Pragma("unroll") for (int n = 0; n < 2; ++n) _Pragma("unroll") for (int k = 0; k < 2; ++k) \
        acc[ai][bj][m][n] = __builtin_amdgcn_mfma_f32_16x16x32_bf16(Bt[n][k], At[m][k], acc[ai][bj][m][n], 0, 0, 0); __builtin_amdgcn_s_setprio(0); } while (0)
#define PG8_WAIT_V(n) asm volatile("s_waitcnt vmcnt(" #n ")" ::: "memory")
#define PG8_WAIT_L(n) asm volatile("s_waitcnt lgkmcnt(" #n ")" ::: "memory")
#define PG8_BAR __builtin_amdgcn_s_barrier()
#define PG8_SCHED __builtin_amdgcn_sched_barrier(0)
    Unit cur, nxt; int ui = 0;
    if (!S.next(0, cur)) return;
    f32x4 acc[2][2][4][2];
#pragma unroll
    for (int a = 0; a < 2; ++a)
#pragma unroll
        for (int b = 0; b < 2; ++b)
#pragma unroll
            for (int m = 0; m < 4; ++m)
#pragma unroll
                for (int n = 0; n < 2; ++n) acc[a][b][m][n] = (f32x4){0.f, 0.f, 0.f, 0.f};
    bf16x8 At[4][2], B0[2][2], B1[2][2];
    const char* cA = (const char*)g.A + (size_t)cur.pm * tstepA; const char* cB = (const char*)g.Bt + (size_t)cur.pn * tstepB;
    S.a_ready(cur);
    if constexpr (SP2) {
        PG8_STAGE(PG8_SB(0, 0), cB, voffB); PG8_STAGE(PG8_SB(0, 1), cB + hstepB, voffB); PG8_STAGE(PG8_SA(0, 0), cA, voffA); PG8_STAGE(PG8_SA(0, 1), cA + hstepA, voffA);
        if (wr == 1) PG8_BAR;
        PG8_WAIT_V(2); PG8_BAR;
        PG8_STAGE(PG8_SB(1, 0), cB + kstep, voffB); PG8_STAGE(PG8_SA(1, 0), cA + kstep, voffA); PG8_STAGE(PG8_SB(1, 1), cB + hstepB + kstep, voffB);
        PG8_WAIT_V(6); PG8_BAR;
    } else {
        PG8_STAGE(PG8_SB(0, 0), cB, voffB); PG8_STAGE(PG8_SA(0, 0), cA, voffA); PG8_STAGE(PG8_SB(0, 1), cB + hstepB, voffB); PG8_STAGE(PG8_SA(0, 1), cA + hstepA, voffA);
        if (wr == 1) PG8_BAR;
        PG8_WAIT_V(4); PG8_BAR;
        PG8_STAGE(PG8_SB(1, 0), cB + kstep, voffB); PG8_STAGE(PG8_SA(1, 0), cA + kstep, voffA); PG8_STAGE(PG8_SB(1, 1), cB + hstepB + kstep, voffB);
        PG8_WAIT_V(6); PG8_BAR;
    }
    for (;;) {
        const bool has_next = S.next(ui + 1, nxt);
        const char* nA = has_next ? (const char*)g.A + (size_t)nxt.pm * tstepA : cA; const char* nB = has_next ? (const char*)g.Bt + (size_t)nxt.pn * tstepB : cB;
        for (int t = 0; t < nt; t += 2) {
            const bool last = (t == nt - 2);
            const char* a1 = cA + (size_t)(t + 1) * kstep;
            const char* a2 = last ? nA : cA + (size_t)(t + 2) * kstep; const char* b2 = last ? nB : cB + (size_t)(t + 2) * kstep;
            const char* a3 = a2 + kstep; const char* b3 = b2 + kstep;
            if (last && has_next) S.a_ready(nxt);
            if constexpr (SP2) {
            PG8_LDB(B0, 0, 0); PG8_LDB(B1, 0, 1); PG8_SCHED; PG8_LDA(At, 0, 0); PG8_STAGE(PG8_SA(1, 1), a1 + hstepA, voffA);
            PG8_WAIT_V(8); PG8_WAIT_L(0); PG8_BAR; PG8_MMA(0, 0, At, B0); PG8_MMA(0, 1, At, B1); PG8_BAR; PG8_SCHED;
            PG8_LDA(At, 0, 1); PG8_STAGE(PG8_SB(0, 0), b2, voffB); PG8_STAGE(PG8_SB(0, 1), b2 + hstepB, voffB); PG8_STAGE(PG8_SA(0, 0), a2, voffA);
            PG8_WAIT_V(8); PG8_WAIT_L(0); PG8_BAR; PG8_MMA(1, 0, At, B0); PG8_MMA(1, 1, At, B1); PG8_BAR; PG8_SCHED;
            PG8_LDB(B0, 1, 0); PG8_LDB(B1, 1, 1); PG8_SCHED; PG8_LDA(At, 1, 0); PG8_STAGE(PG8_SA(0, 1), a2 + hstepA, voffA);
            PG8_WAIT_V(8); PG8_WAIT_L(0); PG8_BAR; PG8_MMA(0, 0, At, B0); PG8_MMA(0, 1, At, B1); PG8_BAR; PG8_SCHED;
            PG8_LDA(At, 1, 1); PG8_STAGE(PG8_SB(1, 0), b3, voffB); PG8_STAGE(PG8_SB(1, 1), b3 + hstepB, voffB); PG8_STAGE(PG8_SA(1, 0), a3, voffA);
            PG8_WAIT_V(8); PG8_WAIT_L(0); PG8_BAR; PG8_MMA(1, 0, At, B0); PG8_MMA(1, 1, At, B1); PG8_BAR; PG8_SCHED;
            } else {
            PG8_LDB(B0, 0, 0); PG8_SCHED; PG8_LDA(At, 0, 0); PG8_STAGE(PG8_SA(1, 1), a1 + hstepA, voffA);
            PG8_WAIT_L(8); PG8_BAR; PG8_WAIT_L(0); PG8_MMA(0, 0, At, B0); PG8_BAR; PG8_SCHED;
            PG8_LDB(B1, 0, 1); PG8_STAGE(PG8_SB(0, 0), b2, voffB);
            PG8_BAR; PG8_WAIT_L(0); PG8_MMA(0, 1, At, B1); PG8_BAR;
            PG8_LDA(At, 0, 1); PG8_STAGE(PG8_SA(0, 0), a2, voffA);
            PG8_BAR; PG8_WAIT_L(0); PG8_MMA(1, 0, At, B0); PG8_BAR; PG8_SCHED;
            PG8_STAGE(PG8_SB(0, 1), b2 + hstepB, voffB);
            PG8_WAIT_V(6); PG8_BAR; PG8_MMA(1, 1, At, B1); PG8_BAR;
            PG8_LDB(B0, 1, 0); PG8_SCHED; PG8_LDA(At, 1, 0); PG8_STAGE(PG8_SA(0, 1), a2 + hstepA, voffA);
            PG8_WAIT_L(8); PG8_BAR; PG8_WAIT_L(0); PG8_MMA(0, 0, At, B0); PG8_BAR; PG8_SCHED;
            PG8_LDB(B1, 1, 1); PG8_STAGE(PG8_SB(1, 0), b3, voffB);
            PG8_BAR; PG8_WAIT_L(0); PG8_MMA(0, 1, At, B1); PG8_BAR;
            PG8_LDA(At, 1, 1); PG8_STAGE(PG8_SA(1, 0), a3, voffA);
            PG8_BAR; PG8_WAIT_L(0); PG8_MMA(1, 0, At, B0); PG8_BAR; PG8_SCHED;
            PG8_STAGE(PG8_SB(1, 1), b3 + hstepB, voffB);
            PG8_WAIT_V(6); PG8_BAR; PG8_MMA(1, 1, At, B1); PG8_BAR;
            }
        }
        if constexpr (ALIGN_EPI) { if (wr == 0) PG8_BAR; }
        if constexpr (!Epi::AFTER_DRAIN) { E(acc, cur, wr, wc, fr, fq); S.done(cur); }
        if (!has_next) break;
#pragma unroll
        for (int a = 0; a < 2; ++a)
#pragma unroll
            for (int b = 0; b < 2; ++b)
#pragma unroll
                for (int m = 0; m < 4; ++m)
#pragma unroll
                    for (int n = 0; n < 2; ++n) acc[a][b][m][n] = (f32x4){0.f, 0.f, 0.f, 0.f};
        cur = nxt; cA = nA; cB = nB; ++ui;
        if constexpr (ALIGN_EPI) { if (wr == 1) PG8_BAR; }
    }
    PG8_WAIT_V(0);
    if constexpr (!ALIGN_EPI) { if (wr == 0) PG8_BAR; }
    PG8_BAR;
    if constexpr (Epi::AFTER_DRAIN) { E.fused(acc, cur, wr, wc, fr, fq, lds, wid, lane); S.done(cur); }
#undef PG8_SA
#undef PG8_SB
#undef PG8_STAGE
#undef PG8_LDA
#undef PG8_LDB
#undef PG8_MMA
#undef PG8_WAIT_V
#undef PG8_WAIT_L
#undef PG8_BAR
#undef PG8_SCHED
}
}
namespace pg8 {
struct EpiF32 {
    static constexpr bool PERM = false, AFTER_DRAIN = false;
    float* O; int ldc;
    __device__ __forceinline__ void operator()(const f32x4 (&acc)[2][2][4][2], const Unit& u, int wr, int wc, int fr, int fq) const {
        const int row0 = u.pm * BM + wr * 64 + fr, col0 = u.pn * BM + wc * 32 + 4 * fq;
#pragma unroll
        for (int ai = 0; ai < 2; ++ai)
#pragma unroll
            for (int m = 0; m < 4; ++m) { float* rowp = O + (size_t)(row0 + ai * HALF + m * 16) * ldc + col0;
#pragma unroll
                for (int bj = 0; bj < 2; ++bj)
#pragma unroll
                    for (int n = 0; n < 2; ++n) *(f32x4*)(rowp + bj * HALF + n * 16) = acc[ai][bj][m][n]; }
    }
};
struct EpiBf16Row {
    static constexpr bool PERM = true, AFTER_DRAIN = false;
    bf16_t* O; int ldc; const float* R; int ridx;
    __device__ __forceinline__ void operator()(const f32x4 (&acc)[2][2][4][2], const Unit& u, int wr, int wc, int fr, int fq) const {
        const int row0 = u.pm * BM + wr * 64 + fr, col0 = u.pn * BM + wc * 32 + 8 * fq;
#pragma unroll
        for (int ai = 0; ai < 2; ++ai)
#pragma unroll
            for (int m = 0; m < 4; ++m) { const int r = row0 + ai * HALF + m * 16; const float sc = R[(size_t)r * 2 + ridx]; bf16_t* rowp = O + (size_t)r * ldc + col0;
#pragma unroll
                for (int bj = 0; bj < 2; ++bj) { const f32x4 v0 = acc[ai][bj][m][0] * sc, v1 = acc[ai][bj][m][1] * sc;
                    u32x4 w; w.x = cvt_pk_bf16(v0[0], v0[1]); w.y = cvt_pk_bf16(v0[2], v0[3]); w.z = cvt_pk_bf16(v1[0], v1[1]); w.w = cvt_pk_bf16(v1[2], v1[3]);
                    *(u32x4*)(rowp + bj * HALF) = w; } }
    }
};
}

namespace cg = cooperative_groups;
#define LAS __attribute__((address_space(3)))
typedef unsigned short bf16;
typedef unsigned v4u __attribute__((ext_vector_type(4)));
typedef unsigned v2u __attribute__((ext_vector_type(2)));
typedef float f32x4 __attribute__((ext_vector_type(4)));
typedef float f32x2 __attribute__((ext_vector_type(2)));

constexpr int NT = 16384, SEQ = 8192, DM = 1024, ZP = 2304, QP = 512, FF = 2816, FF2 = 5632, NCOLS = 2208;
constexpr float EPS = 1e-6f;
constexpr float LOG2E = 1.4426950408889634f;
constexpr int ZA_Q = 0, ZA_K = 256, ZA_V = 512, ZB_CQ = 768, ZB_CKV = 1024, ZB_KR = 1152, ZC_Q = 1184, ZC_K = 1440, ZC_V = 1568, ZD_Q = 1696, ZD_K = 1952, ZD_V = 2080;
constexpr size_t MiB = 1u << 20;
constexpr size_t WS_TABF = 0, WS_TABM = 2 * MiB, WS_R = 3 * MiB;
constexpr size_t WS_WIN = 4 * MiB, WS_WOUT = 9 * MiB, WS_WUP = 11 * MiB, WS_WDOWN = 22 * MiB, WS_WUQ = 28 * MiB, WS_WUKV = 28 * MiB + 512 * 1024;
constexpr size_t WS_H = 29 * MiB, WS_BIG = 61 * MiB;
constexpr size_t WS_Z = WS_BIG, WS_QB = WS_BIG + 72 * MiB, WS_KVB = WS_QB + 16 * MiB, WS_MIX = WS_KVB + 16 * MiB, WS_Y = WS_BIG;
constexpr size_t WS_U = WS_BIG, WS_G = WS_BIG + 88 * MiB, WS_END = WS_G + 88 * MiB;
static_assert(WS_END <= 256 * MiB, "ws");
constexpr int LDS_BYTES = 147456;

struct Args { const float* in[19]; float* out; unsigned char* ws; };

__device__ __forceinline__ unsigned f2bf(float f) { unsigned u = __builtin_bit_cast(unsigned, f); return (u + 0x7fffu + ((u >> 16) & 1u)) >> 16; }
__device__ __forceinline__ unsigned pk2(float lo, float hi) { return f2bf(lo) | (f2bf(hi) << 16); }
__device__ __forceinline__ float bf2f(unsigned b) { return __uint_as_float(b << 16); }
__device__ __forceinline__ float bflo(unsigned w) { return __uint_as_float(w << 16); }
__device__ __forceinline__ float bfhi(unsigned w) { return __uint_as_float(w & 0xffff0000u); }
__device__ __forceinline__ float wave_sum(float v) {
#pragma unroll
    for (int o = 1; o < 64; o <<= 1) v += __shfl_xor(v, o);
    return v;
}
#define LDS_WAIT() asm volatile("s_waitcnt lgkmcnt(0)" ::: "memory")

__device__ __forceinline__ void transpose_item(const float* W, int K, int N, bf16* WT, const float* kscale, LAS float* scr, int item, int lane) {
    const int nblk = N / 32, kb = item / nblk, nb = item % nblk, k0 = 64 * kb, n0 = 32 * nb;
#pragma unroll 8
    for (int i = 0; i < 32; ++i) { const int kk = 2 * i + (lane >> 5); float w = W[(size_t)(k0 + kk) * N + n0 + (lane & 31)]; if (kscale) w *= kscale[k0 + kk]; scr[kk * 33 + (lane & 31)] = w; }
    LDS_WAIT(); asm volatile("" ::: "memory");
    const int c = lane & 7;
#pragma unroll
    for (int j = 0; j < 4; ++j) { const int n = (lane >> 3) + 8 * j; const LAS float* s = scr + (8 * c) * 33 + n;
        v4u o; o.x = pk2(s[0 * 33], s[1 * 33]); o.y = pk2(s[2 * 33], s[3 * 33]); o.z = pk2(s[4 * 33], s[5 * 33]); o.w = pk2(s[6 * 33], s[7 * 33]);
        *(v4u*)(WT + (size_t)(n0 + n) * K + k0 + 8 * c) = o; }
    LDS_WAIT(); asm volatile("" ::: "memory");
}
__device__ __forceinline__ void convert_weights(const Args& a, int l, unsigned char* ws, LAS unsigned char* lds, int gw, int NGW, int wave, int lane, int gtid, int NGT) {
    LAS float* scr = (LAS float*)(lds + wave * 16384);
    constexpr int I_IN = (DM / 64) * (NCOLS / 32), I_OUT = (DM / 64) * (DM / 32), I_UP = (DM / 64) * (FF2 / 32), I_DN = (FF / 64) * (DM / 32), I_UQ = (256 / 64) * (384 / 32), I_UKV = (128 / 64) * (512 / 32);
    constexpr int NITEMS = I_IN + I_OUT + I_UP + I_DN + I_UQ + I_UKV;
    const float* w_in = a.in[2] + (size_t)l * DM * NCOLS; const float* w_out = a.in[11] + (size_t)l * DM * DM; const float* w_up = a.in[14] + (size_t)l * DM * FF2;
    const float* w_dn = a.in[17] + (size_t)l * FF * DM; const float* w_uq = a.in[5] + (size_t)l * 256 * 384; const float* w_ukv = a.in[7] + (size_t)l * 128 * 512;
    const float* gq = a.in[4] + l * 256; const float* gkv = a.in[6] + l * 128;
    for (int it = gw; it < NITEMS; it += NGW) {
        int r = it;
        if (r < I_IN) { transpose_item(w_in, DM, NCOLS, (bf16*)(ws + WS_WIN), nullptr, scr, r, lane); continue; } r -= I_IN;
        if (r < I_OUT) { transpose_item(w_out, DM, DM, (bf16*)(ws + WS_WOUT), nullptr, scr, r, lane); continue; } r -= I_OUT;
        if (r < I_UP) { transpose_item(w_up, DM, FF2, (bf16*)(ws + WS_WUP), nullptr, scr, r, lane); continue; } r -= I_UP;
        if (r < I_DN) { transpose_item(w_dn, FF, DM, (bf16*)(ws + WS_WDOWN), nullptr, scr, r, lane); continue; } r -= I_DN;
        if (r < I_UQ) { transpose_item(w_uq, 256, 384, (bf16*)(ws + WS_WUQ), gq, scr, r, lane); continue; } r -= I_UQ;
        transpose_item(w_ukv, 128, 512, (bf16*)(ws + WS_WUKV), gkv, scr, r, lane);
    }
    { v4u z = {0u, 0u, 0u, 0u};
      v4u* p1 = (v4u*)(ws + WS_WIN + (size_t)NCOLS * DM * 2); for (int i = gtid; i < (ZP - NCOLS) * DM * 2 / 16; i += NGT) p1[i] = z;
      v4u* p2 = (v4u*)(ws + WS_WUQ + (size_t)384 * 256 * 2); for (int i = gtid; i < 128 * 256 * 2 / 16; i += NGT) p2[i] = z; }
}
__device__ __forceinline__ f32x2 cs_of(float ang) {
    const double rev = (double)ang * 0.15915494309189535; const double fr = rev - __builtin_rint(rev); const float f = (float)fr;
    f32x2 r; r.x = __builtin_amdgcn_cosf(f); r.y = __builtin_amdgcn_sinf(f); return r;
}
__device__ __forceinline__ void build_tables(unsigned char* ws, int gtid, int NGT) {
    f32x2* tf = (f32x2*)(ws + WS_TABF); f32x2* tm = (f32x2*)(ws + WS_TABM);
    for (int i = gtid; i < SEQ * 32; i += NGT) { const int t = i >> 5, k = i & 31; const float inv = (float)exp2(-(double)(2 * k) / 64.0 * 13.287712379549449); tf[i] = cs_of((float)t * inv); }
    for (int i = gtid; i < SEQ * 16; i += NGT) { const int t = i >> 4, k = i & 15; const float inv = (float)exp2(-(double)(2 * k) / 32.0 * 13.287712379549449); tm[i] = cs_of((float)t * inv); }
}
__device__ __forceinline__ void norm_row_to_bf16(const float* xrow, const float* g, bf16* orow, int lane) {
    const f32x4* xr = (const f32x4*)xrow + lane; const f32x4* gr = (const f32x4*)g + lane;
    f32x4 v[4]; float s = 0.f;
#pragma unroll
    for (int j = 0; j < 4; ++j) { v[j] = xr[64 * j]; s += (v[j].x * v[j].x + v[j].y * v[j].y) + (v[j].z * v[j].z + v[j].w * v[j].w); }
    const float r = 1.0f / sqrtf(wave_sum(s) * (1.f / DM) + EPS);
    v2u* o8 = (v2u*)orow + lane;
#pragma unroll
    for (int j = 0; j < 4; ++j) { const f32x4 gg = gr[64 * j]; v2u w; w.x = pk2(v[j].x * r * gg.x, v[j].y * r * gg.y); w.y = pk2(v[j].z * r * gg.z, v[j].w * r * gg.w); o8[64 * j] = w; }
}
__device__ __forceinline__ void resnorm_row(const float* yrow, const float* xin, const float* gpost, float* xout, const float* gnext, bf16* hrow, int lane) {
    const f32x4* yr = (const f32x4*)yrow + lane; const f32x4* xr = (const f32x4*)xin + lane; const f32x4* gp = (const f32x4*)gpost + lane; f32x4* xo = (f32x4*)xout + lane;
    f32x4 v[4]; float s = 0.f;
#pragma unroll
    for (int j = 0; j < 4; ++j) { v[j] = yr[64 * j]; s += (v[j].x * v[j].x + v[j].y * v[j].y) + (v[j].z * v[j].z + v[j].w * v[j].w); }
    const float r = 1.0f / sqrtf(wave_sum(s) * (1.f / DM) + EPS); float s2 = 0.f;
#pragma unroll
    for (int j = 0; j < 4; ++j) { const f32x4 xx = xr[64 * j], gg = gp[64 * j]; v[j] = xx + v[j] * r * gg; xo[64 * j] = v[j]; s2 += (v[j].x * v[j].x + v[j].y * v[j].y) + (v[j].z * v[j].z + v[j].w * v[j].w); }
    if (hrow) { const float r2 = 1.0f / sqrtf(wave_sum(s2) * (1.f / DM) + EPS); const f32x4* gn = (const f32x4*)gnext + lane; v2u* o8 = (v2u*)hrow + lane;
#pragma unroll
        for (int j = 0; j < 4; ++j) { const f32x4 gg = gn[64 * j]; v2u w; w.x = pk2(v[j].x * r2 * gg.x, v[j].y * r2 * gg.y); w.y = pk2(v[j].z * r2 * gg.z, v[j].w * r2 * gg.w); o8[64 * j] = w; } }
}
__device__ __forceinline__ void rope4_store(bf16* p, int i, float n0, float n1, float n2, float n3, f32x2 ta, f32x2 tb, bool axial, bool st) {
    float o0, o1, o2, o3;
    if (axial) { o0 = n0 * ta.x - n1 * ta.y; o1 = n1 * ta.x + n0 * ta.y; o2 = n2 * tb.x - n3 * tb.y; o3 = n3 * tb.x + n2 * tb.y; }
    else { o0 = n0 * ta.x - n2 * ta.y; o2 = n2 * ta.x + n0 * ta.y; o1 = n1 * tb.x - n3 * tb.y; o3 = n3 * tb.x + n1 * tb.y; }
    if (st) { p[i] = (bf16)f2bf(o0); p[16 + i] = (bf16)f2bf(o1); p[32 + i] = (bf16)f2bf(o2); p[48 + i] = (bf16)f2bf(o3); }
}
__device__ __forceinline__ void fixup_row(bf16* zr, int s, const f32x2* tabF, const f32x2* tabM, const float* gq, const float* gk, float* R2, int lane) {
    { const v2u w = *(const v2u*)(zr + ZB_CQ + 4 * lane); const float a0 = bflo(w.x), a1 = bfhi(w.x), a2 = bflo(w.y), a3 = bfhi(w.y);
      const float ss = wave_sum((a0 * a0 + a1 * a1) + (a2 * a2 + a3 * a3));
      const unsigned w2 = *(const unsigned*)(zr + ZB_CKV + 2 * lane); const float b0 = bflo(w2), b1 = bfhi(w2);
      const float ss2 = wave_sum(b0 * b0 + b1 * b1);
      if (lane == 0) { R2[0] = 1.0f / sqrtf(ss * (1.f / 256.f) + EPS); R2[1] = 1.0f / sqrtf(ss2 * (1.f / 128.f) + EPS); } }
    const int hh = lane >> 4, i = lane & 15, row = s >> 6, col = s & 63;
    const f32x2 tr = tabM[row * 16 + i], tc = tabM[col * 16 + i], tf0 = tabF[s * 32 + i], tf1 = tabF[s * 32 + 16 + i], tm = tabM[s * 16 + i];
    { const float x1 = bf2f(zr[ZB_KR + i]), x2 = bf2f(zr[ZB_KR + 16 + i]);
      if (lane < 16) { zr[ZB_KR + i] = (bf16)f2bf(x1 * tm.x - x2 * tm.y); zr[ZB_KR + 16 + i] = (bf16)f2bf(x2 * tm.x + x1 * tm.y); } }
    { bf16* p = zr + ZC_Q + hh * 64; const float e0 = bf2f(p[i]), e1 = bf2f(p[16 + i]), e2 = bf2f(p[32 + i]), e3 = bf2f(p[48 + i]);
      float ss = (e0 * e0 + e1 * e1) + (e2 * e2 + e3 * e3); ss += __shfl_xor(ss, 1); ss += __shfl_xor(ss, 2); ss += __shfl_xor(ss, 4); ss += __shfl_xor(ss, 8);
      const float r = 1.0f / sqrtf(ss * (1.f / 64.f) + EPS);
      rope4_store(p, i, e0 * r * gq[i], e1 * r * gq[16 + i], e2 * r * gq[32 + i], e3 * r * gq[48 + i], tr, tc, true, true); }
    { bf16* p = zr + ZC_K + (hh & 1) * 64; const float e0 = bf2f(p[i]), e1 = bf2f(p[16 + i]), e2 = bf2f(p[32 + i]), e3 = bf2f(p[48 + i]);
      float ss = (e0 * e0 + e1 * e1) + (e2 * e2 + e3 * e3); ss += __shfl_xor(ss, 1); ss += __shfl_xor(ss, 2); ss += __shfl_xor(ss, 4); ss += __shfl_xor(ss, 8);
      const float r = 1.0f / sqrtf(ss * (1.f / 64.f) + EPS);
      rope4_store(p, i, e0 * r * gk[i], e1 * r * gk[16 + i], e2 * r * gk[32 + i], e3 * r * gk[48 + i], tr, tc, true, lane < 32); }
    { bf16* p = zr + ZD_Q + hh * 64; const float e0 = bf2f(p[i]), e1 = bf2f(p[16 + i]), e2 = bf2f(p[32 + i]), e3 = bf2f(p[48 + i]);
      rope4_store(p, i, e0, e1, e2, e3, tf0, tf1, false, true); }
    { bf16* p = zr + ZD_K + (hh & 1) * 64; const float e0 = bf2f(p[i]), e1 = bf2f(p[16 + i]), e2 = bf2f(p[32 + i]), e3 = bf2f(p[48 + i]);
      rope4_store(p, i, e0, e1, e2, e3, tf0, tf1, false, lane < 32); }
}
__device__ __forceinline__ void unpack8(const v4u w, float* f) { f[0] = bflo(w.x); f[1] = bfhi(w.x); f[2] = bflo(w.y); f[3] = bfhi(w.y); f[4] = bflo(w.z); f[5] = bfhi(w.z); f[6] = bflo(w.w); f[7] = bfhi(w.w); }
template <int MODE> __device__ __forceinline__ void naive_attn_unit(const bf16* Z, const bf16* QB, const bf16* KVB, bf16* MIX, const f32x2* tabM, const float* rpb, const float* sink,
                                                                     int b, int head, int qblk, LAS unsigned char* lds, int tid) {
    constexpr int DQ = (MODE == 1) ? 96 : 64;
    LAS float* Ks = (LAS float*)lds; LAS float* Vs = Ks + 64 * DQ; LAS float* Bs = Vs + 64 * 64;
    const int s = qblk * 512 + tid; const size_t t = (size_t)b * SEQ + s; const size_t tb = (size_t)b * SEQ;
    const bf16* qp; const bf16* Ksrc; const bf16* Vsrc; int kp, vp; float scale;
    if (MODE == 0) { qp = Z + t * ZP + ZA_Q + head * 64; Ksrc = Z + tb * ZP + ZA_K + head * 64; Vsrc = Z + tb * ZP + ZA_V + head * 64; kp = ZP; vp = ZP; scale = 0.125f; }
    else if (MODE == 1) { qp = QB + t * QP + head * 96; Ksrc = KVB + tb * QP + head * 128; Vsrc = KVB + tb * QP + head * 128 + 64; kp = QP; vp = QP; scale = 0.10206207261596577f; }
    else if (MODE == 2) { qp = Z + t * ZP + ZC_Q + head * 64; Ksrc = Z + tb * ZP + ZC_K + (head >> 1) * 64; Vsrc = Z + tb * ZP + ZC_V + (head >> 1) * 64; kp = ZP; vp = ZP; scale = 0.125f; }
    else { qp = Z + t * ZP + ZD_Q + head * 64; Ksrc = Z + tb * ZP + ZD_K + (head >> 1) * 64; Vsrc = Z + tb * ZP + ZD_V + (head >> 1) * 64; kp = ZP; vp = ZP; scale = 0.125f; }
    const bf16* K2src = Z + tb * ZP + ZB_KR;
    const float c2 = scale * LOG2E;
    float q[DQ];
#pragma unroll
    for (int d = 0; d < DQ; d += 8) unpack8(*(const v4u*)(qp + d), q + d);
    if (MODE == 1) {
#pragma unroll
        for (int i = 0; i < 16; ++i) { const f32x2 cs = tabM[s * 16 + i]; const float x1 = q[64 + i], x2 = q[80 + i]; q[64 + i] = x1 * cs.x - x2 * cs.y; q[80 + i] = x2 * cs.x + x1 * cs.y; }
    }
    int lo = 0, hi = 128;
    const int r = s >> 6, c = s & 63;
    const int rs = min(max(r - 4, 0), 120), cs0 = min(max(c - 8, 0), 48);
    if (MODE == 0) { const int r0 = qblk * 8; lo = min(max(r0 - 4, 0), 120); hi = min(max(r0 + 7 - 4, 0), 120) + 8; __syncthreads(); if (tid < 465) Bs[tid] = rpb[head * 465 + tid] * LOG2E; }
    if (MODE == 3) { lo = max(qblk * 8 - 2, 0); hi = min(qblk * 8 + 10, 128); }
    float m = -1e30f, l = 0.f; float o[64];
#pragma unroll
    for (int d = 0; d < 64; ++d) o[d] = 0.f;
    if (MODE == 3) { m = sink[head] * LOG2E; l = 1.f; }
    for (int kt = lo; kt < hi; ++kt) {
        __syncthreads();
        { const int j = tid >> 3, ch = tid & 7; float f[8];
          unpack8(*(const v4u*)(Ksrc + (size_t)(kt * 64 + j) * kp + ch * 8), f);
          *(LAS f32x4*)(Ks + j * DQ + ch * 8) = (f32x4){f[0], f[1], f[2], f[3]}; *(LAS f32x4*)(Ks + j * DQ + ch * 8 + 4) = (f32x4){f[4], f[5], f[6], f[7]};
          unpack8(*(const v4u*)(Vsrc + (size_t)(kt * 64 + j) * vp + ch * 8), f);
          *(LAS f32x4*)(Vs + j * 64 + ch * 8) = (f32x4){f[0], f[1], f[2], f[3]}; *(LAS f32x4*)(Vs + j * 64 + ch * 8 + 4) = (f32x4){f[4], f[5], f[6], f[7]};
          if (MODE == 1 && tid < 256) { const int j2 = tid >> 2, c2i = tid & 3; unpack8(*(const v4u*)(K2src + (size_t)(kt * 64 + j2) * ZP + c2i * 8), f);
            *(LAS f32x4*)(Ks + j2 * DQ + 64 + c2i * 8) = (f32x4){f[0], f[1], f[2], f[3]}; *(LAS f32x4*)(Ks + j2 * DQ + 64 + c2i * 8 + 4) = (f32x4){f[4], f[5], f[6], f[7]}; } }
        __syncthreads();
        const bool rowok = (MODE != 0) || (kt >= rs && kt < rs + 8);
        if (rowok) {
            for (int j = 0; j < 64; ++j) {
                bool valid = true;
                if (MODE == 0) valid = (j >= cs0 && j < cs0 + 16);
                if (MODE == 3) { const int d = s - (kt * 64 + j); valid = (d <= 128 && d >= -128); }
                if (valid) {
                    float a0 = 0.f, a1 = 0.f, a2 = 0.f, a3 = 0.f;
#pragma unroll
                    for (int d = 0; d < DQ; d += 4) { const f32x4 k4 = *(const LAS f32x4*)(Ks + j * DQ + d); a0 += q[d] * k4.x; a1 += q[d + 1] * k4.y; a2 += q[d + 2] * k4.z; a3 += q[d + 3] * k4.w; }
                    float s2 = ((a0 + a1) + (a2 + a3)) * c2;
                    if (MODE == 0) s2 += Bs[(kt - r + 7) * 31 + (j - c + 15)];
                    if (s2 > m) { const float al = __builtin_amdgcn_exp2f(m - s2); l *= al;
#pragma unroll
                        for (int d = 0; d < 64; ++d) o[d] *= al;
                        m = s2; }
                    const float p = __builtin_amdgcn_exp2f(s2 - m); l += p;
#pragma unroll
                    for (int d = 0; d < 64; d += 4) { const f32x4 v4 = *(const LAS f32x4*)(Vs + j * 64 + d); o[d] += p * v4.x; o[d + 1] += p * v4.y; o[d + 2] += p * v4.z; o[d + 3] += p * v4.w; }
                }
            }
        }
    }
    const float inv = 1.0f / l;
    bf16* op = MIX + t * DM + MODE * 256 + head * 64;
#pragma unroll
    for (int d = 0; d < 64; d += 8) { v4u w; w.x = pk2(o[d] * inv, o[d + 1] * inv); w.y = pk2(o[d + 2] * inv, o[d + 3] * inv); w.z = pk2(o[d + 4] * inv, o[d + 5] * inv); w.w = pk2(o[d + 6] * inv, o[d + 7] * inv); *(v4u*)(op + d) = w; }
}
__device__ __forceinline__ float gelu_tanh(float x) {
    const float z = 0.7978845608028654f * (x + 0.044715f * x * x * x);
    const float e = __builtin_amdgcn_exp2f(z * (2.0f * LOG2E));
    const float th = 1.0f - 2.0f * __builtin_amdgcn_rcpf(e + 1.0f);
    return 0.5f * x * (1.0f + th);
}
__device__ __forceinline__ void conv_phase(const bf16* U, bf16* Gout  , const float* cw, const float* cb, int gtid, int NGT) {
    constexpr int CG = FF / 8, RC = 16;
    for (int item = gtid; item < (SEQ / RC) * CG; item += NGT) {
        const int cgi = item % CG, rc = item / CG, n = cgi * 8, s0 = rc * RC;
        float wg[3][8], wv[3][8], bg[8], bv[8];
#pragma unroll
        for (int i = 0; i < 3; ++i) {
#pragma unroll
            for (int e = 0; e < 8; e += 4) { const f32x4 a = *(const f32x4*)(cw + (size_t)i * FF2 + n + e), bq = *(const f32x4*)(cw + (size_t)i * FF2 + FF + n + e);
                wg[i][e] = a.x; wg[i][e + 1] = a.y; wg[i][e + 2] = a.z; wg[i][e + 3] = a.w; wv[i][e] = bq.x; wv[i][e + 1] = bq.y; wv[i][e + 2] = bq.z; wv[i][e + 3] = bq.w; } }
#pragma unroll
        for (int e = 0; e < 8; e += 4) { const f32x4 a = *(const f32x4*)(cb + n + e), bq = *(const f32x4*)(cb + FF + n + e);
            bg[e] = a.x; bg[e + 1] = a.y; bg[e + 2] = a.z; bg[e + 3] = a.w; bv[e] = bq.x; bv[e + 1] = bq.y; bv[e + 2] = bq.z; bv[e + 3] = bq.w; }
        float pg[8], pv[8], cgv[8], cv[8], ng[8], nv[8];
        if (s0 > 0) { unpack8(*(const v4u*)(U + (size_t)(s0 - 1) * FF2 + n), pg); unpack8(*(const v4u*)(U + (size_t)(s0 - 1) * FF2 + FF + n), pv); }
        else {
#pragma unroll
            for (int e = 0; e < 8; ++e) { pg[e] = 0.f; pv[e] = 0.f; } }
        unpack8(*(const v4u*)(U + (size_t)s0 * FF2 + n), cgv); unpack8(*(const v4u*)(U + (size_t)s0 * FF2 + FF + n), cv);
        for (int rr = 0; rr < RC; ++rr) {
            const int s = s0 + rr;
            if (s + 1 < SEQ) { unpack8(*(const v4u*)(U + (size_t)(s + 1) * FF2 + n), ng); unpack8(*(const v4u*)(U + (size_t)(s + 1) * FF2 + FF + n), nv); }
            else {
#pragma unroll
                for (int e = 0; e < 8; ++e) { ng[e] = 0.f; nv[e] = 0.f; } }
            float res[8];
#pragma unroll
            for (int e = 0; e < 8; ++e) { const float gate = bg[e] + pg[e] * wg[0][e] + cgv[e] * wg[1][e] + ng[e] * wg[2][e]; const float val = bv[e] + pv[e] * wv[0][e] + cv[e] * wv[1][e] + nv[e] * wv[2][e];
                res[e] = gelu_tanh(gate) * val; }
            v4u w; w.x = pk2(res[0], res[1]); w.y = pk2(res[2], res[3]); w.z = pk2(res[4], res[5]); w.w = pk2(res[6], res[7]);
            *(v4u*)(Gout + (size_t)s * FF + n) = w;
#pragma unroll
            for (int e = 0; e < 8; ++e) { pg[e] = cgv[e]; pv[e] = cv[e]; cgv[e] = ng[e]; cv[e] = nv[e]; }
        }
    }
}

__global__ void __launch_bounds__(512, 2) fwd(Args a) {
    extern __shared__ __attribute__((aligned(16))) unsigned char lds_raw[];
    cg::grid_group grid = cg::this_grid();
    LAS unsigned char* lds = (LAS unsigned char*)lds_raw;
#define PHASE_IDS int tid_ = threadIdx.x; asm volatile("" : "+v"(tid_)); const int tid = tid_, lane = tid & 63, wave = __builtin_amdgcn_readfirstlane(tid >> 6), G = gridDim.x, bx = blockIdx.x; \
    const int gw = bx * 8 + wave, NGW = G * 8, gtid = bx * 512 + tid, NGT = G * 512; (void)lane; (void)gw; (void)NGW; (void)gtid; (void)NGT;
    unsigned char* ws = a.ws;
#define WinT ((bf16*)(ws + WS_WIN))
#define WoutT ((bf16*)(ws + WS_WOUT))
#define WupT ((bf16*)(ws + WS_WUP))
#define WdnT ((bf16*)(ws + WS_WDOWN))
#define WuqT ((bf16*)(ws + WS_WUQ))
#define WukvT ((bf16*)(ws + WS_WUKV))
#define H ((bf16*)(ws + WS_H))
#define Z ((bf16*)(ws + WS_Z))
#define QB ((bf16*)(ws + WS_QB))
#define KVB ((bf16*)(ws + WS_KVB))
#define MIX ((bf16*)(ws + WS_MIX))
#define Y ((float*)(ws + WS_Y))
#define U ((bf16*)(ws + WS_U))
#define Gb ((bf16*)(ws + WS_G))
#define R ((float*)(ws + WS_R))
#define tabF ((const f32x2*)(ws + WS_TABF))
#define tabM ((const f32x2*)(ws + WS_TABM))
#define x0 (a.in[0])
#define out (a.out)


    { PHASE_IDS
    convert_weights(a, 0, ws, lds, gw, NGW, wave, lane, gtid, NGT);
#ifndef NO_TAB
    build_tables(ws, gtid, NGT);
#endif
    for (int t = gw; t < NT; t += NGW) norm_row_to_bf16(x0 + (size_t)t * DM, a.in[1], H + (size_t)t * DM, lane);
    }
    grid.sync();

#pragma unroll 1
    for (int l = 0; l < 2; ++l) {
        { const int G = gridDim.x, bx = blockIdx.x; pg8::Gemm g{H, WinT, NT, ZP, DM, DM, DM}; pg8::StaticOrder S; S.init(NT, ZP, G, bx);
          pg8::EpiBf16<0> E{Z, ZP, nullptr, 0, 0, 1.f};
          pg8::gemm_phase<pg8::EpiBf16<0>, pg8::StaticOrder, true, true>(lds, g, S, E); }
        grid.sync();
#ifndef NO_FIX
        { PHASE_IDS
        for (int t = gw; t < NT; t += NGW) fixup_row(Z + (size_t)t * ZP, t & (SEQ - 1), tabF, tabM, a.in[8] + l * 64, a.in[9] + l * 64, R + (size_t)t * 2, lane); }
#endif
        grid.sync();
        { const int G = gridDim.x, bx = blockIdx.x; pg8::Gemm g{Z + ZB_CQ, WuqT, NT, 512, 256, ZP, 256}; pg8::StaticOrder S; S.init(NT, 512, G, bx);
          pg8::EpiBf16Row E{QB, QP, R, 0};
          pg8::gemm_phase<pg8::EpiBf16Row, pg8::StaticOrder, true, true>(lds, g, S, E); }
        { const int G = gridDim.x, bx = blockIdx.x; pg8::Gemm g{Z + ZB_CKV, WukvT, NT, 512, 128, ZP, 128}; pg8::StaticOrder S; S.init(NT, 512, G, (bx + G / 2) % G);
          pg8::EpiBf16Row E{KVB, QP, R, 1};
          pg8::gemm_phase<pg8::EpiBf16Row, pg8::StaticOrder, true, true>(lds, g, S, E); }
        grid.sync();
#ifndef NO_ATTN
        { PHASE_IDS
        for (int u = bx; u < 512; u += G) {
            const int kind = u >> 7, v = u & 127, b = v >> 6, head = (v >> 4) & 3, qblk = v & 15;
            const float* rpb = a.in[3] + (size_t)l * 4 * 465; const float* sink = a.in[10] + l * 4;
            if (kind == 0) naive_attn_unit<1>(Z, QB, KVB, MIX, tabM, rpb, sink, b, head, qblk, lds, tid);
            else if (kind == 1) naive_attn_unit<2>(Z, QB, KVB, MIX, tabM, rpb, sink, b, head, qblk, lds, tid);
            else if (kind == 2) naive_attn_unit<0>(Z, QB, KVB, MIX, tabM, rpb, sink, b, head, qblk, lds, tid);
            else naive_attn_unit<3>(Z, QB, KVB, MIX, tabM, rpb, sink, b, head, qblk, lds, tid);
            __syncthreads();
        } }
#endif
        grid.sync();
        { const int G = gridDim.x, bx = blockIdx.x; pg8::Gemm g{MIX, WoutT, NT, DM, DM, DM, DM}; pg8::StaticOrder S; S.init(NT, DM, G, bx);
          pg8::EpiF32 E{Y, DM};
          pg8::gemm_phase<pg8::EpiF32, pg8::StaticOrder, true, true>(lds, g, S, E); }
        grid.sync();
        { PHASE_IDS const float* xin = (l == 0) ? x0 : out;
          for (int t = gw; t < NT; t += NGW) resnorm_row(Y + (size_t)t * DM, xin + (size_t)t * DM, a.in[12] + l * DM, out + (size_t)t * DM, a.in[13] + l * DM, H + (size_t)t * DM, lane); }
        grid.sync();
#pragma unroll 1
        for (int hb = 0; hb < 2; ++hb) {
            { const int G = gridDim.x, bx = blockIdx.x; pg8::Gemm g{H + (size_t)hb * SEQ * DM, WupT, SEQ, FF2, DM, DM, DM}; pg8::StaticOrder S; S.init(SEQ, FF2, G, bx);
              pg8::EpiBf16<0> E{U, FF2, nullptr, 0, 0, 1.f};
              pg8::gemm_phase<pg8::EpiBf16<0>, pg8::StaticOrder, true, true>(lds, g, S, E); }
            grid.sync();
#ifndef NO_CONV
            { PHASE_IDS conv_phase(U, Gb + (size_t)hb * SEQ * FF, a.in[15] + (size_t)l * 3 * FF2, a.in[16] + (size_t)l * FF2, gtid, NGT); }
#endif
            grid.sync();
        }
        { const int G = gridDim.x, bx = blockIdx.x; pg8::Gemm g{Gb, WdnT, NT, DM, FF, FF, FF}; pg8::StaticOrder S; S.init(NT, DM, G, bx);
          pg8::EpiF32 E{Y, DM};
          pg8::gemm_phase<pg8::EpiF32, pg8::StaticOrder, true, true>(lds, g, S, E); }
        grid.sync();
        { PHASE_IDS
        for (int t = gw; t < NT; t += NGW) resnorm_row(Y + (size_t)t * DM, out + (size_t)t * DM, a.in[18] + l * DM, out + (size_t)t * DM, a.in[1] + DM, (l == 0) ? H + (size_t)t * DM : nullptr, lane);
        if (l == 0) { convert_weights(a, 1, ws, lds, gw, NGW, wave, lane, gtid, NGT); } }
        if (l == 0) grid.sync();
    }
}

#undef WinT
#undef WoutT
#undef WupT
#undef WdnT
#undef WuqT
#undef WukvT
#undef H
#undef Z
#undef QB
#undef KVB
#undef MIX
#undef Y
#undef U
#undef Gb
#undef R
#undef tabF
#undef tabM
#undef x0
#undef out
extern "C" void kernel_launch(void* const* d_in, const int* in_sizes, int n_in, void* d_out, int out_size, void* d_ws, size_t ws_size, hipStream_t stream) {
    static int grid = 0;
    if (grid == 0) {
        int dev = 0, cus = 0, per_cu = 0;
        hipGetDevice(&dev); hipDeviceGetAttribute(&cus, hipDeviceAttributeMultiprocessorCount, dev);
        hipFuncSetAttribute((const void*)fwd, hipFuncAttributeMaxDynamicSharedMemorySize, LDS_BYTES);
        hipOccupancyMaxActiveBlocksPerMultiprocessor(&per_cu, (const void*)fwd, 512, LDS_BYTES);
        if (per_cu < 1) { fprintf(stderr, "occupancy query says %d blocks/CU\n", per_cu); per_cu = 1; }
        grid = cus;
        if (ws_size < WS_END) { fprintf(stderr, "workspace too small: %zu < %zu\n", ws_size, (size_t)WS_END); grid = -1; }
    }
    if (grid < 0) return;
    Args a{};
    for (int i = 0; i < 19; ++i) a.in[i] = (const float*)d_in[i];
    a.out = (float*)d_out; a.ws = (unsigned char*)d_ws;
    void* args[] = {&a};
    hipError_t e = hipLaunchCooperativeKernel((const void*)fwd, dim3(grid), dim3(512), args, LDS_BYTES, stream);
    if (e != hipSuccess) fprintf(stderr, "cooperative launch failed: %s (grid %d)\n", hipGetErrorString(e), grid);
}
```

```cpp
#include <hip/hip_runtime.h>
#include <hip/hip_cooperative_groups.h>
#include <cstdio>
#include <cstdint>
namespace pg8 {
#define PG8_LAS __attribute__((address_space(3)))
typedef unsigned short bf16_t;
typedef short bf16x8 __attribute__((ext_vector_type(8)));
typedef float f32x4 __attribute__((ext_vector_type(4)));
typedef unsigned u32x4 __attribute__((ext_vector_type(4)));
constexpr int BM = 256, BK = 64, HALF = 128, HTB = HALF * BK * 2  , STAGE_BYTES = 8 * HTB, NXCD = 8, WGM = 8;

__host__ __device__ __forceinline__ int lds_byte(int r, int c) { const int st = (r >> 4) * 2 + (c >> 5), rr = r & 15, cc = c & 31, ob = rr * 64 + cc * 2; return st * 1024 + (ob ^ (((ob >> 9) & 1) << 5)); }
__host__ __device__ __forceinline__ void stage_rc(int b, int& R, int& C) { const int st = b / 1024, sb = b % 1024, swz = sb ^ (((sb >> 9) & 1) << 5); R = (st >> 1) * 16 + swz / 64; C = (st & 1) * 32 + (swz % 64) / 2; }
__host__ __device__ __forceinline__ int perm32(int rho) { const int n = rho >> 4, i = rho & 15; return 8 * (i >> 2) + 4 * n + (i & 3); }

struct Unit { int pm, pn; };
struct Gemm { const bf16_t* A; const bf16_t* Bt; int M, N, K, lda, ldb; };

struct StaticOrder {
    int nM, nN, nwg, G, c;
    __host__ __device__ void init(int M, int N, int G_, int c_) { nM = M / BM; nN = N / BM; nwg = nM * nN; G = G_; c = c_; }
    __host__ __device__ bool next(int i, Unit& u) const {
        const long L = (long)i * G + c; if (L >= nwg) return false;
        int wgid = (int)L; { const int q = nwg / NXCD, r = nwg % NXCD, xcd = wgid % NXCD, off = wgid / NXCD; wgid = (xcd < r ? xcd * (q + 1) : r * (q + 1) + (xcd - r) * q) + off; }
        const int nig = WGM * nN, gid = wgid / nig, fm = gid * WGM, gsz = (nM - fm) < WGM ? (nM - fm) : WGM;
        u.pm = fm + ((wgid % nig) % gsz); u.pn = (wgid % nig) / gsz; return true;
    }
    __device__ __forceinline__ void a_ready(const Unit&) const {}
    __device__ __forceinline__ void done(const Unit&) const {}
};

__device__ __forceinline__ unsigned cvt_pk_bf16(float lo, float hi) { unsigned r; asm volatile("v_cvt_pk_bf16_f32 %0, %1, %2" : "=v"(r) : "v"(lo), "v"(hi)); return r; }
typedef float f32x2 __attribute__((ext_vector_type(2)));
__device__ __forceinline__ f32x2 gelu_pk(f32x2 v) {
    const f32x2 av = __builtin_elementwise_abs(v), d = av * 0.2316418882f + 1.0f;
    f32x2 t; t.x = __builtin_amdgcn_rcpf(d.x); t.y = __builtin_amdgcn_rcpf(d.y);
    f32x2 q = t * 0.5307027145f + (-0.7265760135f); q = q * t + 0.7107068705f; q = q * t + (-0.142248368f); q = q * t + 0.127414796f; q = q * t;
    const f32x2 s = (v * v) * (-0.72134752044f);
    f32x2 e; e.x = __builtin_amdgcn_exp2f(s.x); e.y = __builtin_amdgcn_exp2f(s.y);
    const f32x2 m = v * (q * e), r = v - m;
    f32x2 o; o.x = v.x < 0.f ? m.x : r.x; o.y = v.y < 0.f ? m.y : r.y; return o;
}

template <int ACT  > struct EpiBf16 {
    static constexpr bool PERM = true, AFTER_DRAIN = false; static_assert(ACT == 0 || ACT == 1, "EpiBf16: ACT is 0 (none) or 1 (gelu_pk)");
    bf16_t* O; int ldc; const float* bias; int split_cols; size_t split_stride; float scale0;
    __device__ __forceinline__ void operator()(const f32x4 (&acc)[2][2][4][2], const Unit& u, int wr, int wc, int fr, int fq) const {
        const int row0 = u.pm * BM + wr * 64 + fr; int colt = u.pn * BM; bf16_t* base = O;
        float sc = 1.f; if (split_cols) { const int t = colt / split_cols; base += (size_t)t * split_stride; colt -= t * split_cols; if (t == 0) sc = scale0; }
        const int col0 = colt + wc * 32 + 8 * fq, bcol0 = u.pn * BM + wc * 32 + 8 * fq;
        f32x4 bv[2][2];
#pragma unroll
        for (int bj = 0; bj < 2; ++bj)
#pragma unroll
            for (int n = 0; n < 2; ++n) bv[bj][n] = bias ? *(const f32x4*)(bias + bcol0 + bj * HALF + 4 * n) : (f32x4){0.f, 0.f, 0.f, 0.f};
#pragma unroll
        for (int ai = 0; ai < 2; ++ai)
#pragma unroll
            for (int m = 0; m < 4; ++m) { bf16_t* rowp = base + (size_t)(row0 + ai * HALF + m * 16) * ldc + col0;
#pragma unroll
                for (int bj = 0; bj < 2; ++bj) { f32x4 v0 = acc[ai][bj][m][0] + bv[bj][0], v1 = acc[ai][bj][m][1] + bv[bj][1];
                    if (ACT == 1) { f32x2 a = gelu_pk((f32x2){v0[0], v0[1]}), b = gelu_pk((f32x2){v0[2], v0[3]}), c = gelu_pk((f32x2){v1[0], v1[1]}), d = gelu_pk((f32x2){v1[2], v1[3]});
                        v0 = (f32x4){a.x, a.y, b.x, b.y}; v1 = (f32x4){c.x, c.y, d.x, d.y}; }
                    v0 = v0 * sc; v1 = v1 * sc; u32x4 w; w.x = cvt_pk_bf16(v0[0], v0[1]); w.y = cvt_pk_bf16(v0[2], v0[3]); w.z = cvt_pk_bf16(v1[0], v1[1]); w.w = cvt_pk_bf16(v1[2], v1[3]);
                    *(u32x4*)(rowp + bj * HALF) = w; } }
    }
};

struct PanelStats {
    unsigned* xbuf;
    unsigned* cnt;
    unsigned* tmo;
    int ntn; float eps;
    unsigned code;
    __device__ __forceinline__ bool run(const f32x4 (&v)[2][2][4][2], const Unit& u, int wr, int wc, int fr, int fq, PG8_LAS unsigned char* lds, int wid, int lane) const {
        typedef float f32x2v __attribute__((ext_vector_type(2)));
        PG8_LAS f32x2v* P = (PG8_LAS f32x2v*)lds;
        PG8_LAS f32x2v* S = (PG8_LAS f32x2v*)(lds + 8192);
        PG8_LAS unsigned* flag = (PG8_LAS unsigned*)(lds + 8192 + 2048);
#pragma unroll
        for (int ai = 0; ai < 2; ++ai)
#pragma unroll
            for (int m = 0; m < 4; ++m) {
                float s = 0.f;
#pragma unroll
                for (int bj = 0; bj < 2; ++bj)
#pragma unroll
                    for (int n = 0; n < 2; ++n) { const f32x4 x = v[ai][bj][m][n]; s += (x[0] + x[1]) + (x[2] + x[3]); }
                s += __shfl_xor(s, 16); s += __shfl_xor(s, 32);
                const float mw = s * (1.0f / 64.0f); float q = 0.f;
#pragma unroll
                for (int bj = 0; bj < 2; ++bj)
#pragma unroll
                    for (int n = 0; n < 2; ++n) { const f32x4 d = v[ai][bj][m][n] - mw; q += (d[0] * d[0] + d[1] * d[1]) + (d[2] * d[2] + d[3] * d[3]); }
                q += __shfl_xor(q, 16); q += __shfl_xor(q, 32);
                if (fq == 0) P[(ai * HALF + wr * 64 + m * 16 + fr) * 4 + wc] = (f32x2v){mw, q};
            }
        asm volatile("s_waitcnt lgkmcnt(0)" ::: "memory"); __builtin_amdgcn_s_barrier(); asm volatile("" ::: "memory");
#if defined(BROKEN_EXCHANGE_NO_WAIT)
#warning BROKEN CONTROL BUILD: the row-statistics exchange does not wait; results are wrong by design
        if (blockIdx.x >= 64) { const long long t0_ = clock64(); while (clock64() - t0_ < 60000) __builtin_amdgcn_s_sleep(8); }
#endif
        const int row = wid * 32 + (lane & 31);
        if (lane < 32) {
            const f32x2v a = P[row * 4 + 0], b = P[row * 4 + 1], c = P[row * 4 + 2], d = P[row * 4 + 3];
            const float mt = (a.x + b.x + c.x + d.x) * 0.25f;
            const float da = a.x - mt, db = b.x - mt, dc = c.x - mt, dd = d.x - mt;
            const float m2 = (a.y + b.y) + (c.y + d.y) + 64.0f * ((da * da + db * db) + (dc * dc + dd * dd));
            unsigned long long* slot = (unsigned long long*)xbuf + ((size_t)(u.pm * BM + row) * 4 + u.pn);
            __hip_atomic_store(slot, ((unsigned long long)__float_as_uint(m2) << 32) | __float_as_uint(mt), __ATOMIC_RELAXED, __HIP_MEMORY_SCOPE_AGENT);
        }
        asm volatile("s_waitcnt vmcnt(0)" ::: "memory");
        if (lane == 0) __hip_atomic_fetch_add(cnt + 64 * u.pm, 1u, __ATOMIC_RELAXED, __HIP_MEMORY_SCOPE_AGENT);
        if (wid == 0) {
            bool dead = false; const unsigned long long t0 = __builtin_amdgcn_s_memrealtime(); const unsigned want = 8u * (unsigned)ntn;
            for (;;) {
#if defined(BROKEN_EXCHANGE_NO_WAIT)
                break;
#endif
                if ((unsigned)__builtin_amdgcn_readfirstlane(__hip_atomic_load(cnt + 64 * u.pm, __ATOMIC_RELAXED, __HIP_MEMORY_SCOPE_AGENT)) >= want) break;
                if (__builtin_amdgcn_s_memrealtime() - t0 > 2000000ull) {
                    if (lane == 0) { unsigned expect = 0u; __hip_atomic_compare_exchange_strong(tmo + 1, &expect, code | (unsigned)(u.pm & 0xff), __ATOMIC_RELAXED, __ATOMIC_RELAXED, __HIP_MEMORY_SCOPE_AGENT);
                                     __hip_atomic_store(tmo, 1u, __ATOMIC_RELAXED, __HIP_MEMORY_SCOPE_AGENT); }
                    dead = true; break; }
                __builtin_amdgcn_s_sleep(2);
            }
            __builtin_amdgcn_fence(__ATOMIC_ACQUIRE, "agent");
            if (lane == 0) flag[0] = dead ? 1u : 0u;
        }
        asm volatile("s_waitcnt vmcnt(0) lgkmcnt(0)" ::: "memory"); __builtin_amdgcn_s_barrier(); asm volatile("" ::: "memory");
        const bool bad = flag[0] != 0u;
        if (lane < 32) {
            const unsigned long long* slot = (const unsigned long long*)xbuf + (size_t)(u.pm * BM + row) * 4; float mt[4], m2[4]; float ms = 0.f;
#pragma unroll
            for (int t = 0; t < 4; ++t) { if (t < ntn) { const unsigned long long w = __hip_atomic_load(slot + t, __ATOMIC_RELAXED, __HIP_MEMORY_SCOPE_AGENT); mt[t] = __uint_as_float((unsigned)w); m2[t] = __uint_as_float((unsigned)(w >> 32)); } else { mt[t] = 0.f; m2[t] = 0.f; } ms += mt[t]; }
            const float mean = ms / (float)ntn; float q = 0.f;
#pragma unroll
            for (int t = 0; t < 4; ++t) if (t < ntn) { const float dm = mt[t] - mean; q += m2[t] + 256.0f * dm * dm; }
            S[row] = (f32x2v){mean, 1.0f / sqrtf(q / (256.0f * (float)ntn) + eps)};
        }
        asm volatile("s_waitcnt lgkmcnt(0)" ::: "memory"); __builtin_amdgcn_s_barrier(); asm volatile("" ::: "memory");
        return bad;
    }
};
struct EpiLnRes {
    static constexpr bool PERM = false, AFTER_DRAIN = true;
    const float* base; float* out; int ldc; const float* bias; PanelStats st; unsigned poison;
    __device__ __forceinline__ void fused(f32x4 (&acc)[2][2][4][2], const Unit& u, int wr, int wc, int fr, int fq, PG8_LAS unsigned char* lds, int wid, int lane) const {
        typedef float f32x2v __attribute__((ext_vector_type(2)));
        const PG8_LAS f32x2v* S = (const PG8_LAS f32x2v*)(lds + 8192);
        const int col0 = u.pn * BM + wc * 32 + 4 * fq;
#pragma unroll
        for (int bj = 0; bj < 2; ++bj)
#pragma unroll
            for (int n = 0; n < 2; ++n) { const f32x4 bv = bias ? *(const f32x4*)(bias + col0 + bj * HALF + n * 16) : (f32x4){0.f, 0.f, 0.f, 0.f};
#pragma unroll
                for (int ai = 0; ai < 2; ++ai)
#pragma unroll
                    for (int m = 0; m < 4; ++m) acc[ai][bj][m][n] += bv; }
        f32x4 pre[4][2][2];
#pragma unroll
        for (int m = 0; m < 4; ++m) { const size_t off = (size_t)(u.pm * BM + wr * 64 + m * 16 + fr) * ldc + col0;
#pragma unroll
            for (int bj = 0; bj < 2; ++bj)
#pragma unroll
                for (int n = 0; n < 2; ++n) pre[m][bj][n] = *(const f32x4*)(base + off + bj * HALF + n * 16); }
        const bool bad = st.run(acc, u, wr, wc, fr, fq, lds, wid, lane) || poison != 0u;
        const float qnan = __builtin_nanf("");
#pragma unroll
        for (int ai = 0; ai < 2; ++ai)
#pragma unroll
            for (int m = 0; m < 4; ++m) { const int r = ai * HALF + wr * 64 + m * 16 + fr; const f32x2v sr = S[r]; const size_t off = (size_t)(u.pm * BM + r) * ldc + col0;
#pragma unroll
                for (int bj = 0; bj < 2; ++bj)
#pragma unroll
                    for (int n = 0; n < 2; ++n) { const f32x4 bs = ai == 0 ? pre[m][bj][n] : *(const f32x4*)(base + off + bj * HALF + n * 16); f32x4 o = bs + (acc[ai][bj][m][n] - sr.x) * sr.y;
                        if (bad) o = (f32x4){qnan, qnan, qnan, qnan}; *(f32x4*)(out + off + bj * HALF + n * 16) = o; }
                if (m & 1) asm volatile("" ::: "memory"); }
    }
};
struct EpiLnResLn {
    static constexpr bool PERM = false, AFTER_DRAIN = true;
    const float* base; float* out; bf16_t* xn; int ldc; const float* bias; PanelStats st1, st2; unsigned poison;
    __device__ __forceinline__ void fused(f32x4 (&acc)[2][2][4][2], const Unit& u, int wr, int wc, int fr, int fq, PG8_LAS unsigned char* lds, int wid, int lane) const {
        typedef float f32x2v __attribute__((ext_vector_type(2))); typedef unsigned u32x2v __attribute__((ext_vector_type(2)));
        const PG8_LAS f32x2v* S = (const PG8_LAS f32x2v*)(lds + 8192);
        const int col0 = u.pn * BM + wc * 32 + 4 * fq;
#pragma unroll
        for (int bj = 0; bj < 2; ++bj)
#pragma unroll
            for (int n = 0; n < 2; ++n) { const f32x4 bv = bias ? *(const f32x4*)(bias + col0 + bj * HALF + n * 16) : (f32x4){0.f, 0.f, 0.f, 0.f};
#pragma unroll
                for (int ai = 0; ai < 2; ++ai)
#pragma unroll
                    for (int m = 0; m < 4; ++m) acc[ai][bj][m][n] += bv; }
        bool bad = st1.run(acc, u, wr, wc, fr, fq, lds, wid, lane) || poison != 0u;
        const float qnan = __builtin_nanf("");
#pragma unroll
        for (int ai = 0; ai < 2; ++ai)
#pragma unroll
            for (int m = 0; m < 4; ++m) { const int r = ai * HALF + wr * 64 + m * 16 + fr; const f32x2v sr = S[r]; const size_t off = (size_t)(u.pm * BM + r) * ldc + col0;
#pragma unroll
                for (int bj = 0; bj < 2; ++bj)
#pragma unroll
                    for (int n = 0; n < 2; ++n) { const f32x4 bs = *(const f32x4*)(base + off + bj * HALF + n * 16); acc[ai][bj][m][n] = bs + (acc[ai][bj][m][n] - sr.x) * sr.y; }
                asm volatile("" : "+v"(acc[ai][0][m][0]), "+v"(acc[ai][0][m][1]), "+v"(acc[ai][1][m][0]), "+v"(acc[ai][1][m][1]));
                if (m & 1) asm volatile("" ::: "memory"); }
        const bool bad1 = bad;
        bad = st2.run(acc, u, wr, wc, fr, fq, lds, wid, lane) || bad;
#pragma unroll
        for (int ai = 0; ai < 2; ++ai)
#pragma unroll
            for (int m = 0; m < 4; ++m) { const int r = ai * HALF + wr * 64 + m * 16 + fr; const f32x2v sr = S[r]; const size_t off = (size_t)(u.pm * BM + r) * ldc + col0;
#pragma unroll
                for (int bj = 0; bj < 2; ++bj)
#pragma unroll
                    for (int n = 0; n < 2; ++n) { const f32x4 x1 = acc[ai][bj][m][n]; *(f32x4*)(out + off + bj * HALF + n * 16) = bad1 ? (f32x4){qnan, qnan, qnan, qnan} : x1;
                        const f32x4 o = (x1 - sr.x) * sr.y; u32x2v w; w.x = cvt_pk_bf16(o[0], o[1]); w.y = cvt_pk_bf16(o[2], o[3]);
                        if (bad) { w.x = 0x7fc07fc0u; w.y = 0x7fc07fc0u; } *(u32x2v*)(xn + off + bj * HALF + n * 16) = w; }
                asm volatile("" ::: "memory"); }
    }
};

template <class Epi, class Sched, bool ALIGN_EPI = false, bool SP2 = false>
__device__ __forceinline__ void gemm_phase(PG8_LAS unsigned char* lds, const Gemm g, const Sched& S, const Epi& E) {
    int tid_ = threadIdx.x; asm volatile("" : "+v"(tid_));
    const int tid = tid_, wid = __builtin_amdgcn_readfirstlane(tid >> 6), lane = tid & 63, wr = wid >> 2, wc = wid & 3, fr = lane & 15, fq = lane >> 4;
    int K_ = g.K, lda_ = g.lda, ldb_ = g.ldb; asm volatile("" : "+s"(K_), "+s"(lda_), "+s"(ldb_));
    const int K = K_, nt = K / BK;
    unsigned voffA[2], voffB[2];
#pragma unroll
    for (int i = 0; i < 2; ++i) { int R, C; stage_rc(tid * 16 + i * 8192, R, C); const int Rb = Epi::PERM ? ((R & ~31) + perm32(R & 31)) : R;
        voffA[i] = (unsigned)(R * lda_ + C) * 2u; voffB[i] = (unsigned)(Rb * ldb_ + C) * 2u; }
    const size_t kstep = (size_t)(BK * 2);
    const size_t hstepA = (size_t)HALF * lda_ * 2, hstepB = (size_t)HALF * ldb_ * 2;
    const size_t tstepA = 2 * hstepA, tstepB = 2 * hstepB;
    const unsigned ldsw = (unsigned)wid * 1024u;
    const int aoff = lds_byte(wr * 64 + fr, fq * 8), boff = lds_byte(wc * 32 + fr, fq * 8);
#define PG8_SA(b, h) (((b) * 2 + (h)) * HTB)
#define PG8_SB(b, h) ((4 + (b) * 2 + (h)) * HTB)
#define PG8_STAGE(bufoff, gbase, voff) do { _Pragma("unroll") for (int _i = 0; _i < 2; ++_i) \
        __builtin_amdgcn_global_load_lds((const unsigned*)((const char*)(gbase) + (voff)[_i]), (PG8_LAS unsigned*)(lds + (bufoff) + ldsw + _i * 8192), 16, 0, 0); } while (0)
#define PG8_LDA(dst, b, h) do { _Pragma("unroll") for (int m = 0; m < 4; ++m) _Pragma("unroll") for (int k = 0; k < 2; ++k) dst[m][k] = *(const PG8_LAS bf16x8*)(lds + PG8_SA(b, h) + aoff + m * 2048 + k * 1024); } while (0)
#define PG8_LDB(dst, b, h) do { _Pragma("unroll") for (int n = 0; n < 2; ++n) _Pragma("unroll") for (int k = 0; k < 2; ++k) dst[n][k] = *(const PG8_LAS bf16x8*)(lds + PG8_SB(b, h) + boff + n * 2048 + k * 1024); } while (0)
#define PG8_MMA(ai, bj, At, Bt) do { __builtin_amdgcn_s_setprio(1); _Pragma("unroll") for (int m = 0; m < 4; ++m) _Pragma("unroll") for (int n = 0; n < 2; ++n) _Pragma("unroll") for (int k = 0; k < 2; ++k) \
        acc[ai][bj][m][n] = __builtin_amdgcn_mfma_f32_16x16x32_bf16(Bt[n][k], At[m][k], acc[ai][bj][m][n], 0, 0, 0); __builtin_amdgcn_s_setprio(0); } while (0)
#define PG8_WAIT_V(n) asm volatile("s_waitcnt vmcnt(" #n ")" ::: "memory")
#define PG8_WAIT_L(n) asm volatile("s_waitcnt lgkmcnt(" #n ")" ::: "memory")
#define PG8_BAR __builtin_amdgcn_s_barrier()
#define PG8_SCHED __builtin_amdgcn_sched_barrier(0)
    Unit cur, nxt; int ui = 0;
    if (!S.next(0, cur)) return;
    f32x4 acc[2][2][4][2];
#pragma unroll
    for (int a = 0; a < 2; ++a)
#pragma unroll
        for (int b = 0; b < 2; ++b)
#pragma unroll
            for (int m = 0; m < 4; ++m)
#pragma unroll
                for (int n = 0; n < 2; ++n) acc[a][b][m][n] = (f32x4){0.f, 0.f, 0.f, 0.f};
    bf16x8 At[4][2], B0[2][2], B1[2][2];
    const char* cA = (const char*)g.A + (size_t)cur.pm * tstepA; const char* cB = (const char*)g.Bt + (size_t)cur.pn * tstepB;
    S.a_ready(cur);
    if constexpr (SP2) {
        PG8_STAGE(PG8_SB(0, 0), cB, voffB); PG8_STAGE(PG8_SB(0, 1), cB + hstepB, voffB); PG8_STAGE(PG8_SA(0, 0), cA, voffA); PG8_STAGE(PG8_SA(0, 1), cA + hstepA, voffA);
        if (wr == 1) PG8_BAR;
        PG8_WAIT_V(2); PG8_BAR;
        PG8_STAGE(PG8_SB(1, 0), cB + kstep, voffB); PG8_STAGE(PG8_SA(1, 0), cA + kstep, voffA); PG8_STAGE(PG8_SB(1, 1), cB + hstepB + kstep, voffB);
        PG8_WAIT_V(6); PG8_BAR;
    } else {
        PG8_STAGE(PG8_SB(0, 0), cB, voffB); PG8_STAGE(PG8_SA(0, 0), cA, voffA); PG8_STAGE(PG8_SB(0, 1), cB + hstepB, voffB); PG8_STAGE(PG8_SA(0, 1), cA + hstepA, voffA);
        if (wr == 1) PG8_BAR;
        PG8_WAIT_V(4); PG8_BAR;
        PG8_STAGE(PG8_SB(1, 0), cB + kstep, voffB); PG8_STAGE(PG8_SA(1, 0), cA + kstep, voffA); PG8_STAGE(PG8_SB(1, 1), cB + hstepB + kstep, voffB);
        PG8_WAIT_V(6); PG8_BAR;
    }
    for (;;) {
        const bool has_next = S.next(ui + 1, nxt);
        const char* nA = has_next ? (const char*)g.A + (size_t)nxt.pm * tstepA : cA; const char* nB = has_next ? (const char*)g.Bt + (size_t)nxt.pn * tstepB : cB;
        for (int t = 0; t < nt; t += 2) {
            const bool last = (t == nt - 2);
            const char* a1 = cA + (size_t)(t + 1) * kstep;
            const char* a2 = last ? nA : cA + (size_t)(t + 2) * kstep; const char* b2 = last ? nB : cB + (size_t)(t + 2) * kstep;
            const char* a3 = a2 + kstep; const char* b3 = b2 + kstep;
            if (last && has_next) S.a_ready(nxt);
            if constexpr (SP2) {
            PG8_LDB(B0, 0, 0); PG8_LDB(B1, 0, 1); PG8_SCHED; PG8_LDA(At, 0, 0); PG8_STAGE(PG8_SA(1, 1), a1 + hstepA, voffA);
            PG8_WAIT_V(8); PG8_WAIT_L(0); PG8_BAR; PG8_MMA(0, 0, At, B0); PG8_MMA(0, 1, At, B1); PG8_BAR; PG8_SCHED;
            PG8_LDA(At, 0, 1); PG8_STAGE(PG8_SB(0, 0), b2, voffB); PG8_STAGE(PG8_SB(0, 1), b2 + hstepB, voffB); PG8_STAGE(PG8_SA(0, 0), a2, voffA);
            PG8_WAIT_V(8); PG8_WAIT_L(0); PG8_BAR; PG8_MMA(1, 0, At, B0); PG8_MMA(1, 1, At, B1); PG8_BAR; PG8_SCHED;
            PG8_LDB(B0, 1, 0); PG8_LDB(B1, 1, 1); PG8_SCHED; PG8_LDA(At, 1, 0); PG8_STAGE(PG8_SA(0, 1), a2 + hstepA, voffA);
            PG8_WAIT_V(8); PG8_WAIT_L(0); PG8_BAR; PG8_MMA(0, 0, At, B0); PG8_MMA(0, 1, At, B1); PG8_BAR; PG8_SCHED;
            PG8_LDA(At, 1, 1); PG8_STAGE(PG8_SB(1, 0), b3, voffB); PG8_STAGE(PG8_SB(1, 1), b3 + hstepB, voffB); PG8_STAGE(PG8_SA(1, 0), a3, voffA);
            PG8_WAIT_V(8); PG8_WAIT_L(0); PG8_BAR; PG8_MMA(1, 0, At, B0); PG8_MMA(1, 1, At, B1); PG8_BAR; PG8_SCHED;
            } else {
            PG8_LDB(B0, 0, 0); PG8_SCHED; PG8_LDA(At, 0, 0); PG8_STAGE(PG8_SA(1, 1), a1 + hstepA, voffA);
            PG8_WAIT_L(8); PG8_BAR; PG8_WAIT_L(0); PG8_MMA(0, 0, At, B0); PG8_BAR; PG8_SCHED;
            PG8_LDB(B1, 0, 1); PG8_STAGE(PG8_SB(0, 0), b2, voffB);
            PG8_BAR; PG8_WAIT_L(0); PG8_MMA(0, 1, At, B1); PG8_BAR;
            PG8_LDA(At, 0, 1); PG8_STAGE(PG8_SA(0, 0), a2, voffA);
            PG8_BAR; PG8_WAIT_L(0); PG8_MMA(1, 0, At, B0); PG8_BAR; PG8_SCHED;
            PG8_STAGE(PG8_SB(0, 1), b2 + hstepB, voffB);
            PG8_WAIT_V(6); PG8_BAR; PG8_MMA(1, 1, At, B1); PG8_BAR;
            PG8_LDB(B0, 1, 0); PG8_SCHED; PG8_LDA(At, 1, 0); PG8_STAGE(PG8_SA(0, 1), a2 + hstepA, voffA);
            PG8_WAIT_L(8); PG8_BAR; PG8_WAIT_L(0); PG8_MMA(0, 0, At, B0); PG8_BAR; PG8_SCHED;
            PG8_LDB(B1, 1, 1); PG8_STAGE(PG8_SB(1, 0), b3, voffB);
            PG8_BAR; PG8_WAIT_L(0); PG8_MMA(0, 1, At, B1); PG8_BAR;
            PG8_LDA(At, 1, 1); PG8_STAGE(PG8_SA(1, 0), a3, voffA);
            PG8_BAR; PG8_WAIT_L(0); PG8_MMA(1, 0, At, B0); PG8_BAR; PG8_SCHED;
            PG8_STAGE(PG8_SB(1, 1), b3 + hstepB, voffB);
            PG8_WAIT_V(6); PG8_BAR; PG8_MMA(1, 1, At, B1); PG8_BAR;
            }
        }
        if constexpr (ALIGN_EPI) { if (wr == 0) PG8_BAR; }
        if constexpr (!Epi::AFTER_DRAIN) { E(acc, cur, wr, wc, fr, fq); S.done(cur); }
        if (!has_next) break;
#pragma unroll
        for (int a = 0; a < 2; ++a)
#pragma unroll
            for (int b = 0; b < 2; ++b)
#pragma unroll
                for (int m = 0; m < 4; ++m)
#pragma unroll
                    for (int n = 0; n < 2; ++n) acc[a][b][m][n] = (f32x4){0.f, 0.f, 0.f, 0.f};
        cur = nxt; cA = nA; cB = nB; ++ui;
        if constexpr (ALIGN_EPI) { if (wr == 1) PG8_BAR; }
    }
    PG8_WAIT_V(0);
    if constexpr (!ALIGN_EPI) { if (wr == 0) PG8_BAR; }
    PG8_BAR;
    if constexpr (Epi::AFTER_DRAIN) { E.fused(acc, cur, wr, wc, fr, fq, lds, wid, lane); S.done(cur); }
#undef PG8_SA
#undef PG8_SB
#undef PG8_STAGE
#undef PG8_LDA
#undef PG8_LDB
#undef PG8_MMA
#undef PG8_WAIT_V
#undef PG8_WAIT_L
#undef PG8_BAR
#undef PG8_SCHED
}
}
namespace pg8 {
struct EpiF32 {
    static constexpr bool PERM = false, AFTER_DRAIN = false;
    float* O; int ldc;
    __device__ __forceinline__ void operator()(const f32x4 (&acc)[2][2][4][2], const Unit& u, int wr, int wc, int fr, int fq) const {
        const int row0 = u.pm * BM + wr * 64 + fr, col0 = u.pn * BM + wc * 32 + 4 * fq;
#pragma unroll
        for (int ai = 0; ai < 2; ++ai)
#pragma unroll
            for (int m = 0; m < 4; ++m) { float* rowp = O + (size_t)(row0 + ai * HALF + m * 16) * ldc + col0;
#pragma unroll
                for (int bj = 0; bj < 2; ++bj)
#pragma unroll
                    for (int n = 0; n < 2; ++n) *(f32x4*)(rowp + bj * HALF + n * 16) = acc[ai][bj][m][n]; }
    }
};
struct EpiBf16Row {
    static constexpr bool PERM = true, AFTER_DRAIN = false;
    bf16_t* O; int ldc; const float* R; int ridx;
    __device__ __forceinline__ void operator()(const f32x4 (&acc)[2][2][4][2], const Unit& u, int wr, int wc, int fr, int fq) const {
        const int row0 = u.pm * BM + wr * 64 + fr, col0 = u.pn * BM + wc * 32 + 8 * fq;
#pragma unroll
        for (int ai = 0; ai < 2; ++ai)
#pragma unroll
            for (int m = 0; m < 4; ++m) { const int r = row0 + ai * HALF + m * 16; const float sc = R[(size_t)r * 2 + ridx]; bf16_t* rowp = O + (size_t)r * ldc + col0;
#pragma unroll
                for (int bj = 0; bj < 2; ++bj) { const f32x4 v0 = acc[ai][bj][m][0] * sc, v1 = acc[ai][bj][m][1] * sc;
                    u32x4 w; w.x = cvt_pk_bf16(v0[0], v0[1]); w.y = cvt_pk_bf16(v0[2], v0[3]); w.z = cvt_pk_bf16(v1[0], v1[1]); w.w = cvt_pk_bf16(v1[2], v1[3]);
                    *(u32x4*)(rowp + bj * HALF) = w; } }
    }
};
}

namespace cg = cooperative_groups;
#define LAS __attribute__((address_space(3)))
typedef unsigned short bf16;
typedef unsigned v4u __attribute__((ext_vector_type(4)));
typedef unsigned v2u __attribute__((ext_vector_type(2)));
typedef float f32x4 __attribute__((ext_vector_type(4)));
typedef float f32x2 __attribute__((ext_vector_type(2)));

constexpr int NT = 16384, SEQ = 8192, DM = 1024, ZP = 2304, QP = 512, FF = 2816, FF2 = 5632, NCOLS = 2208;
constexpr float EPS = 1e-6f;
constexpr float LOG2E = 1.4426950408889634f;
constexpr int ZA_Q = 0, ZA_K = 256, ZA_V = 512, ZB_CQ = 768, ZB_CKV = 1024, ZB_KR = 1152, ZC_Q = 1184, ZC_K = 1440, ZC_V = 1568, ZD_Q = 1696, ZD_K = 1952, ZD_V = 2080;
constexpr size_t MiB = 1u << 20;
constexpr size_t WS_TABF = 0, WS_TABM = 2 * MiB, WS_R = 3 * MiB;
constexpr size_t WS_WIN = 4 * MiB, WS_WOUT = 9 * MiB, WS_WUP = 11 * MiB, WS_WDOWN = 22 * MiB, WS_WUQ = 28 * MiB, WS_WUKV = 28 * MiB + 512 * 1024;
constexpr size_t WS_H = 29 * MiB, WS_BIG = 61 * MiB;
constexpr size_t WS_Z = WS_BIG, WS_QB = WS_BIG + 72 * MiB, WS_KVB = WS_QB + 16 * MiB, WS_MIX = WS_KVB + 16 * MiB, WS_Y = WS_BIG;
constexpr size_t WS_U = WS_BIG, WS_G = WS_BIG + 88 * MiB, WS_END = WS_G + 88 * MiB;
static_assert(WS_END <= 256 * MiB, "ws");
constexpr int LDS_BYTES = 147456;

struct Args { const float* in[19]; float* out; unsigned char* ws; };

__device__ __forceinline__ unsigned f2bf(float f) { unsigned u = __builtin_bit_cast(unsigned, f); return (u + 0x7fffu + ((u >> 16) & 1u)) >> 16; }
__device__ __forceinline__ unsigned pk2(float lo, float hi) { return f2bf(lo) | (f2bf(hi) << 16); }
__device__ __forceinline__ float bf2f(unsigned b) { return __uint_as_float(b << 16); }
__device__ __forceinline__ float bflo(unsigned w) { return __uint_as_float(w << 16); }
__device__ __forceinline__ float bfhi(unsigned w) { return __uint_as_float(w & 0xffff0000u); }
__device__ __forceinline__ float wave_sum(float v) {
#pragma unroll
    for (int o = 1; o < 64; o <<= 1) v += __shfl_xor(v, o);
    return v;
}
#define LDS_WAIT() asm volatile("s_waitcnt lgkmcnt(0)" ::: "memory")

__device__ __forceinline__ void transpose_item(const float* W, int K, int N, bf16* WT, const float* kscale, LAS float* scr, int item, int lane) {
    const int nblk = N / 32, kb = item / nblk, nb = item % nblk, k0 = 64 * kb, n0 = 32 * nb;
#pragma unroll 8
    for (int i = 0; i < 32; ++i) { const int kk = 2 * i + (lane >> 5); float w = W[(size_t)(k0 + kk) * N + n0 + (lane & 31)]; if (kscale) w *= kscale[k0 + kk]; scr[kk * 33 + (lane & 31)] = w; }
    LDS_WAIT(); asm volatile("" ::: "memory");
    const int c = lane & 7;
#pragma unroll
    for (int j = 0; j < 4; ++j) { const int n = (lane >> 3) + 8 * j; const LAS float* s = scr + (8 * c) * 33 + n;
        v4u o; o.x = pk2(s[0 * 33], s[1 * 33]); o.y = pk2(s[2 * 33], s[3 * 33]); o.z = pk2(s[4 * 33], s[5 * 33]); o.w = pk2(s[6 * 33], s[7 * 33]);
        *(v4u*)(WT + (size_t)(n0 + n) * K + k0 + 8 * c) = o; }
    LDS_WAIT(); asm volatile("" ::: "memory");
}
__device__ __forceinline__ void convert_weights(const Args& a, int l, unsigned char* ws, LAS unsigned char* lds, int gw, int NGW, int wave, int lane, int gtid, int NGT) {
    LAS float* scr = (LAS float*)(lds + wave * 16384);
    constexpr int I_IN = (DM / 64) * (NCOLS / 32), I_OUT = (DM / 64) * (DM / 32), I_UP = (DM / 64) * (FF2 / 32), I_DN = (FF / 64) * (DM / 32), I_UQ = (256 / 64) * (384 / 32), I_UKV = (128 / 64) * (512 / 32);
    constexpr int NITEMS = I_IN + I_OUT + I_UP + I_DN + I_UQ + I_UKV;
    const float* w_in = a.in[2] + (size_t)l * DM * NCOLS; const float* w_out = a.in[11] + (size_t)l * DM * DM; const float* w_up = a.in[14] + (size_t)l * DM * FF2;
    const float* w_dn = a.in[17] + (size_t)l * FF * DM; const float* w_uq = a.in[5] + (size_t)l * 256 * 384; const float* w_ukv = a.in[7] + (size_t)l * 128 * 512;
    const float* gq = a.in[4] + l * 256; const float* gkv = a.in[6] + l * 128;
    for (int it = gw; it < NITEMS; it += NGW) {
        int r = it;
        if (r < I_IN) { transpose_item(w_in, DM, NCOLS, (bf16*)(ws + WS_WIN), nullptr, scr, r, lane); continue; } r -= I_IN;
        if (r < I_OUT) { transpose_item(w_out, DM, DM, (bf16*)(ws + WS_WOUT), nullptr, scr, r, lane); continue; } r -= I_OUT;
        if (r < I_UP) { transpose_item(w_up, DM, FF2, (bf16*)(ws + WS_WUP), nullptr, scr, r, lane); continue; } r -= I_UP;
        if (r < I_DN) { transpose_item(w_dn, FF, DM, (bf16*)(ws + WS_WDOWN), nullptr, scr, r, lane); continue; } r -= I_DN;
        if (r < I_UQ) { transpose_item(w_uq, 256, 384, (bf16*)(ws + WS_WUQ), gq, scr, r, lane); continue; } r -= I_UQ;
        transpose_item(w_ukv, 128, 512, (bf16*)(ws + WS_WUKV), gkv, scr, r, lane);
    }
    { v4u z = {0u, 0u, 0u, 0u};
      v4u* p1 = (v4u*)(ws + WS_WIN + (size_t)NCOLS * DM * 2); for (int i = gtid; i < (ZP - NCOLS) * DM * 2 / 16; i += NGT) p1[i] = z;
      v4u* p2 = (v4u*)(ws + WS_WUQ + (size_t)384 * 256 * 2); for (int i = gtid; i < 128 * 256 * 2 / 16; i += NGT) p2[i] = z; }
}
__device__ __forceinline__ f32x2 cs_of(float ang) {
    const double rev = (double)ang * 0.15915494309189535; const double fr = rev - __builtin_rint(rev); const float f = (float)fr;
    f32x2 r; r.x = __builtin_amdgcn_cosf(f); r.y = __builtin_amdgcn_sinf(f); return r;
}
__device__ __forceinline__ void build_tables(unsigned char* ws, int gtid, int NGT) {
    f32x2* tf = (f32x2*)(ws + WS_TABF); f32x2* tm = (f32x2*)(ws + WS_TABM);
    for (int i = gtid; i < SEQ * 32; i += NGT) { const int t = i >> 5, k = i & 31; const float inv = (float)exp2(-(double)(2 * k) / 64.0 * 13.287712379549449); tf[i] = cs_of((float)t * inv); }
    for (int i = gtid; i < SEQ * 16; i += NGT) { const int t = i >> 4, k = i & 15; const float inv = (float)exp2(-(double)(2 * k) / 32.0 * 13.287712379549449); tm[i] = cs_of((float)t * inv); }
}
__device__ __forceinline__ void norm_row_to_bf16(const float* xrow, const float* g, bf16* orow, int lane) {
    const f32x4* xr = (const f32x4*)xrow + lane; const f32x4* gr = (const f32x4*)g + lane;
    f32x4 v[4]; float s = 0.f;
#pragma unroll
    for (int j = 0; j < 4; ++j) { v[j] = xr[64 * j]; s += (v[j].x * v[j].x + v[j].y * v[j].y) + (v[j].z * v[j].z + v[j].w * v[j].w); }
    const float r = 1.0f / sqrtf(wave_sum(s) * (1.f / DM) + EPS);
    v2u* o8 = (v2u*)orow + lane;
#pragma unroll
    for (int j = 0; j < 4; ++j) { const f32x4 gg = gr[64 * j]; v2u w; w.x = pk2(v[j].x * r * gg.x, v[j].y * r * gg.y); w.y = pk2(v[j].z * r * gg.z, v[j].w * r * gg.w); o8[64 * j] = w; }
}
__device__ __forceinline__ void resnorm_row(const float* yrow, const float* xin, const float* gpost, float* xout, const float* gnext, bf16* hrow, int lane) {
    const f32x4* yr = (const f32x4*)yrow + lane; const f32x4* xr = (const f32x4*)xin + lane; const f32x4* gp = (const f32x4*)gpost + lane; f32x4* xo = (f32x4*)xout + lane;
    f32x4 v[4]; float s = 0.f;
#pragma unroll
    for (int j = 0; j < 4; ++j) { v[j] = yr[64 * j]; s += (v[j].x * v[j].x + v[j].y * v[j].y) + (v[j].z * v[j].z + v[j].w * v[j].w); }
    const float r = 1.0f / sqrtf(wave_sum(s) * (1.f / DM) + EPS); float s2 = 0.f;
#pragma unroll
    for (int j = 0; j < 4; ++j) { const f32x4 xx = xr[64 * j], gg = gp[64 * j]; v[j] = xx + v[j] * r * gg; xo[64 * j] = v[j]; s2 += (v[j].x * v[j].x + v[j].y * v[j].y) + (v[j].z * v[j].z + v[j].w * v[j].w); }
    if (hrow) { const float r2 = 1.0f / sqrtf(wave_sum(s2) * (1.f / DM) + EPS); const f32x4* gn = (const f32x4*)gnext + lane; v2u* o8 = (v2u*)hrow + lane;
#pragma unroll
        for (int j = 0; j < 4; ++j) { const f32x4 gg = gn[64 * j]; v2u w; w.x = pk2(v[j].x * r2 * gg.x, v[j].y * r2 * gg.y); w.y = pk2(v[j].z * r2 * gg.z, v[j].w * r2 * gg.w); o8[64 * j] = w; } }
}
__device__ __forceinline__ void rope4_store(bf16* p, int i, float n0, float n1, float n2, float n3, f32x2 ta, f32x2 tb, bool axial, bool st) {
    float o0, o1, o2, o3;
    if (axial) { o0 = n0 * ta.x - n1 * ta.y; o1 = n1 * ta.x + n0 * ta.y; o2 = n2 * tb.x - n3 * tb.y; o3 = n3 * tb.x + n2 * tb.y; }
    else { o0 = n0 * ta.x - n2 * ta.y; o2 = n2 * ta.x + n0 * ta.y; o1 = n1 * tb.x - n3 * tb.y; o3 = n3 * tb.x + n1 * tb.y; }
    if (st) { p[i] = (bf16)f2bf(o0); p[16 + i] = (bf16)f2bf(o1); p[32 + i] = (bf16)f2bf(o2); p[48 + i] = (bf16)f2bf(o3); }
}
__device__ __forceinline__ void fixup_row(bf16* zr, int s, const f32x2* tabF, const f32x2* tabM, const float* gq, const float* gk, float* R2, int lane) {
    { const v2u w = *(const v2u*)(zr + ZB_CQ + 4 * lane); const float a0 = bflo(w.x), a1 = bfhi(w.x), a2 = bflo(w.y), a3 = bfhi(w.y);
      const float ss = wave_sum((a0 * a0 + a1 * a1) + (a2 * a2 + a3 * a3));
      const unsigned w2 = *(const unsigned*)(zr + ZB_CKV + 2 * lane); const float b0 = bflo(w2), b1 = bfhi(w2);
      const float ss2 = wave_sum(b0 * b0 + b1 * b1);
      if (lane == 0) { R2[0] = 1.0f / sqrtf(ss * (1.f / 256.f) + EPS); R2[1] = 1.0f / sqrtf(ss2 * (1.f / 128.f) + EPS); } }
    const int hh = lane >> 4, i = lane & 15, row = s >> 6, col = s & 63;
    const f32x2 tr = tabM[row * 16 + i], tc = tabM[col * 16 + i], tf0 = tabF[s * 32 + i], tf1 = tabF[s * 32 + 16 + i], tm = tabM[s * 16 + i];
    { const float x1 = bf2f(zr[ZB_KR + i]), x2 = bf2f(zr[ZB_KR + 16 + i]);
      if (lane < 16) { zr[ZB_KR + i] = (bf16)f2bf(x1 * tm.x - x2 * tm.y); zr[ZB_KR + 16 + i] = (bf16)f2bf(x2 * tm.x + x1 * tm.y); } }
    { bf16* p = zr + ZC_Q + hh * 64; const float e0 = bf2f(p[i]), e1 = bf2f(p[16 + i]), e2 = bf2f(p[32 + i]), e3 = bf2f(p[48 + i]);
      float ss = (e0 * e0 + e1 * e1) + (e2 * e2 + e3 * e3); ss += __shfl_xor(ss, 1); ss += __shfl_xor(ss, 2); ss += __shfl_xor(ss, 4); ss += __shfl_xor(ss, 8);
      const float r = 1.0f / sqrtf(ss * (1.f / 64.f) + EPS);
      rope4_store(p, i, e0 * r * gq[i], e1 * r * gq[16 + i], e2 * r * gq[32 + i], e3 * r * gq[48 + i], tr, tc, true, true); }
    { bf16* p = zr + ZC_K + (hh & 1) * 64; const float e0 = bf2f(p[i]), e1 = bf2f(p[16 + i]), e2 = bf2f(p[32 + i]), e3 = bf2f(p[48 + i]);
      float ss = (e0 * e0 + e1 * e1) + (e2 * e2 + e3 * e3); ss += __shfl_xor(ss, 1); ss += __shfl_xor(ss, 2); ss += __shfl_xor(ss, 4); ss += __shfl_xor(ss, 8);
      const float r = 1.0f / sqrtf(ss * (1.f / 64.f) + EPS);
      rope4_store(p, i, e0 * r * gk[i], e1 * r * gk[16 + i], e2 * r * gk[32 + i], e3 * r * gk[48 + i], tr, tc, true, lane < 32); }
    { bf16* p = zr + ZD_Q + hh * 64; const float e0 = bf2f(p[i]), e1 = bf2f(p[16 + i]), e2 = bf2f(p[32 + i]), e3 = bf2f(p[48 + i]);
      rope4_store(p, i, e0, e1, e2, e3, tf0, tf1, false, true); }
    { bf16* p = zr + ZD_K + (hh & 1) * 64; const float e0 = bf2f(p[i]), e1 = bf2f(p[16 + i]), e2 = bf2f(p[32 + i]), e3 = bf2f(p[48 + i]);
      rope4_store(p, i, e0, e1, e2, e3, tf0, tf1, false, lane < 32); }
}
__device__ __forceinline__ void unpack8(const v4u w, float* f) { f[0] = bflo(w.x); f[1] = bfhi(w.x); f[2] = bflo(w.y); f[3] = bfhi(w.y); f[4] = bflo(w.z); f[5] = bfhi(w.z); f[6] = bflo(w.w); f[7] = bfhi(w.w); }
template <int MODE> __device__ __forceinline__ void naive_attn_unit(const bf16* Z, const bf16* QB, const bf16* KVB, bf16* MIX, const f32x2* tabM, const float* rpb, const float* sink,
                                                                     int b, int head, int qblk, LAS unsigned char* lds, int tid) {
    constexpr int DQ = (MODE == 1) ? 96 : 64;
    LAS float* Ks = (LAS float*)lds; LAS float* Vs = Ks + 64 * DQ; LAS float* Bs = Vs + 64 * 64;
    const int s = qblk * 512 + tid; const size_t t = (size_t)b * SEQ + s; const size_t tb = (size_t)b * SEQ;
    const bf16* qp; const bf16* Ksrc; const bf16* Vsrc; int kp, vp; float scale;
    if (MODE == 0) { qp = Z + t * ZP + ZA_Q + head * 64; Ksrc = Z + tb * ZP + ZA_K + head * 64; Vsrc = Z + tb * ZP + ZA_V + head * 64; kp = ZP; vp = ZP; scale = 0.125f; }
    else if (MODE == 1) { qp = QB + t * QP + head * 96; Ksrc = KVB + tb * QP + head * 128; Vsrc = KVB + tb * QP + head * 128 + 64; kp = QP; vp = QP; scale = 0.10206207261596577f; }
    else if (MODE == 2) { qp = Z + t * ZP + ZC_Q + head * 64; Ksrc = Z + tb * ZP + ZC_K + (head >> 1) * 64; Vsrc = Z + tb * ZP + ZC_V + (head >> 1) * 64; kp = ZP; vp = ZP; scale = 0.125f; }
    else { qp = Z + t * ZP + ZD_Q + head * 64; Ksrc = Z + tb * ZP + ZD_K + (head >> 1) * 64; Vsrc = Z + tb * ZP + ZD_V + (head >> 1) * 64; kp = ZP; vp = ZP; scale = 0.125f; }
    const bf16* K2src = Z + tb * ZP + ZB_KR;
    const float c2 = scale * LOG2E;
    float q[DQ];
#pragma unroll
    for (int d = 0; d < DQ; d += 8) unpack8(*(const v4u*)(qp + d), q + d);
    if (MODE == 1) {
#pragma unroll
        for (int i = 0; i < 16; ++i) { const f32x2 cs = tabM[s * 16 + i]; const float x1 = q[64 + i], x2 = q[80 + i]; q[64 + i] = x1 * cs.x - x2 * cs.y; q[80 + i] = x2 * cs.x + x1 * cs.y; }
    }
    int lo = 0, hi = 128;
    const int r = s >> 6, c = s & 63;
    const int rs = min(max(r - 4, 0), 120), cs0 = min(max(c - 8, 0), 48);
    if (MODE == 0) { const int r0 = qblk * 8; lo = min(max(r0 - 4, 0), 120); hi = min(max(r0 + 7 - 4, 0), 120) + 8; __syncthreads(); if (tid < 465) Bs[tid] = rpb[head * 465 + tid] * LOG2E; }
    if (MODE == 3) { lo = max(qblk * 8 - 2, 0); hi = min(qblk * 8 + 10, 128); }
    float m = -1e30f, l = 0.f; float o[64];
#pragma unroll
    for (int d = 0; d < 64; ++d) o[d] = 0.f;
    if (MODE == 3) { m = sink[head] * LOG2E; l = 1.f; }
    for (int kt = lo; kt < hi; ++kt) {
        __syncthreads();
        { const int j = tid >> 3, ch = tid & 7; float f[8];
          unpack8(*(const v4u*)(Ksrc + (size_t)(kt * 64 + j) * kp + ch * 8), f);
          *(LAS f32x4*)(Ks + j * DQ + ch * 8) = (f32x4){f[0], f[1], f[2], f[3]}; *(LAS f32x4*)(Ks + j * DQ + ch * 8 + 4) = (f32x4){f[4], f[5], f[6], f[7]};
          unpack8(*(const v4u*)(Vsrc + (size_t)(kt * 64 + j) * vp + ch * 8), f);
          *(LAS f32x4*)(Vs + j * 64 + ch * 8) = (f32x4){f[0], f[1], f[2], f[3]}; *(LAS f32x4*)(Vs + j * 64 + ch * 8 + 4) = (f32x4){f[4], f[5], f[6], f[7]};
          if (MODE == 1 && tid < 256) { const int j2 = tid >> 2, c2i = tid & 3; unpack8(*(const v4u*)(K2src + (size_t)(kt * 64 + j2) * ZP + c2i * 8), f);
            *(LAS f32x4*)(Ks + j2 * DQ + 64 + c2i * 8) = (f32x4){f[0], f[1], f[2], f[3]}; *(LAS f32x4*)(Ks + j2 * DQ + 64 + c2i * 8 + 4) = (f32x4){f[4], f[5], f[6], f[7]}; } }
        __syncthreads();
        const bool rowok = (MODE != 0) || (kt >= rs && kt < rs + 8);
        if (rowok) {
            for (int j = 0; j < 64; ++j) {
                bool valid = true;
                if (MODE == 0) valid = (j >= cs0 && j < cs0 + 16);
                if (MODE == 3) { const int d = s - (kt * 64 + j); valid = (d <= 128 && d >= -128); }
                if (valid) {
                    float a0 = 0.f, a1 = 0.f, a2 = 0.f, a3 = 0.f;
#pragma unroll
                    for (int d = 0; d < DQ; d += 4) { const f32x4 k4 = *(const LAS f32x4*)(Ks + j * DQ + d); a0 += q[d] * k4.x; a1 += q[d + 1] * k4.y; a2 += q[d + 2] * k4.z; a3 += q[d + 3] * k4.w; }
                    float s2 = ((a0 + a1) + (a2 + a3)) * c2;
                    if (MODE == 0) s2 += Bs[(kt - r + 7) * 31 + (j - c + 15)];
                    if (s2 > m) { const float al = __builtin_amdgcn_exp2f(m - s2); l *= al;
#pragma unroll
                        for (int d = 0; d < 64; ++d) o[d] *= al;
                        m = s2; }
                    const float p = __builtin_amdgcn_exp2f(s2 - m); l += p;
#pragma unroll
                    for (int d = 0; d < 64; d += 4) { const f32x4 v4 = *(const LAS f32x4*)(Vs + j * 64 + d); o[d] += p * v4.x; o[d + 1] += p * v4.y; o[d + 2] += p * v4.z; o[d + 3] += p * v4.w; }
                }
            }
        }
    }
    const float inv = 1.0f / l;
    bf16* op = MIX + t * DM + MODE * 256 + head * 64;
#pragma unroll
    for (int d = 0; d < 64; d += 8) { v4u w; w.x = pk2(o[d] * inv, o[d + 1] * inv); w.y = pk2(o[d + 2] * inv, o[d + 3] * inv); w.z = pk2(o[d + 4] * inv, o[d + 5] * inv); w.w = pk2(o[d + 6] * inv, o[d + 7] * inv); *(v4u*)(op + d) = w; }
}

typedef short bf16x8_t __attribute__((ext_vector_type(8)));
typedef short s16x4_t __attribute__((ext_vector_type(4)));
typedef float f32x16 __attribute__((ext_vector_type(16)));
__device__ __forceinline__ int crow(int r, int hi) { return (r & 3) + 8 * (r >> 2) + 4 * hi; }
__device__ __forceinline__ s16x4_t vtr(const LAS unsigned char* p) { return __builtin_bit_cast(s16x4_t, __builtin_amdgcn_ds_read_tr16_b64_v4i16((LAS s16x4_t*)p)); }
__device__ __forceinline__ unsigned cvtpk(float lo, float hi) { typedef float f2 __attribute__((ext_vector_type(2))); typedef __bf16 b2 __attribute__((ext_vector_type(2))); f2 v = {lo, hi}; b2 b = __builtin_convertvector(v, b2); return __builtin_bit_cast(unsigned, b); }
template <int MODE> __device__ __forceinline__ void fa_unit(const bf16* Zp, const bf16* QBp, const bf16* KVBp, bf16* MIXp, const f32x2* tabMp, const float* rpb, const float* sink,
                                                             int b, int head, int qblk, LAS unsigned char* lds, int tid) {
    constexpr int DQ = (MODE == 1) ? 96 : 64, NC = DQ / 16, PK = DQ * 2 + 16, PV = 192, KBYTES = 64 * PK, VBYTES = 64 * PV, BUF = KBYTES + VBYTES;
    constexpr float THR = 4.0f;
    const int lane = tid & 63, wave = __builtin_amdgcn_readfirstlane(tid >> 6), r32 = lane & 31, hi = lane >> 5;
    LAS float* wsf = (LAS float*)(lds + 2 * BUF) + wave * 32; LAS float* Bs = (LAS float*)(lds + 2 * BUF + 8 * 32 * 4);
    const int q0 = qblk * 256, w0 = q0 + wave * 32, sq = w0 + r32; const size_t tb = (size_t)b * SEQ, t = tb + sq;
    const bf16* qp; const bf16* Ksrc; const bf16* Vsrc; int kp, vp; float scale;
    if (MODE == 0) { qp = Zp + t * ZP + ZA_Q + head * 64; Ksrc = Zp + tb * ZP + ZA_K + head * 64; Vsrc = Zp + tb * ZP + ZA_V + head * 64; kp = ZP; vp = ZP; scale = 0.125f; }
    else if (MODE == 1) { qp = QBp + t * QP + head * 96; Ksrc = KVBp + tb * QP + head * 128; Vsrc = KVBp + tb * QP + head * 128 + 64; kp = QP; vp = QP; scale = 0.10206207261596577f; }
    else if (MODE == 2) { qp = Zp + t * ZP + ZC_Q + head * 64; Ksrc = Zp + tb * ZP + ZC_K + (head >> 1) * 64; Vsrc = Zp + tb * ZP + ZC_V + (head >> 1) * 64; kp = ZP; vp = ZP; scale = 0.125f; }
    else { qp = Zp + t * ZP + ZD_Q + head * 64; Ksrc = Zp + tb * ZP + ZD_K + (head >> 1) * 64; Vsrc = Zp + tb * ZP + ZD_V + (head >> 1) * 64; kp = ZP; vp = ZP; scale = 0.125f; }
    const bf16* K2src = Zp + tb * ZP + ZB_KR;
    const float c2 = scale * LOG2E;
    bf16x8_t qf[NC];
#pragma unroll
    for (int c = 0; c < NC; ++c) qf[c] = *(const bf16x8_t*)(qp + 16 * c + 8 * hi);
    if (MODE == 1) {
#pragma unroll
        for (int j = 0; j < 8; ++j) { const f32x2 cs = tabMp[sq * 16 + 8 * hi + j]; const float x1 = bf2f((unsigned short)qf[NC - 2][j]), x2 = bf2f((unsigned short)qf[NC - 1][j]);
            qf[NC - 2][j] = (short)f2bf(x1 * cs.x - x2 * cs.y); qf[NC - 1][j] = (short)f2bf(x2 * cs.x + x1 * cs.y); }
    }
    int lo = 0, hit = 128;
    const int rw = w0 >> 6, rs = min(max(rw - 4, 0), 120), cq = sq & 63, cs0 = min(max(cq - 8, 0), 48);
    if (MODE == 0) { const int r0 = qblk * 4; lo = min(max(r0 - 4, 0), 120); hit = min(max(r0 + 3 - 4, 0), 120) + 8; if (tid < 465) Bs[tid] = rpb[head * 465 + tid] * LOG2E; }
    if (MODE == 3) { lo = max(qblk * 4 - 2, 0); hit = min(qblk * 4 + 6, 128); }
    f32x16 o0, o1;
#pragma unroll
    for (int r = 0; r < 16; ++r) { o0[r] = 0.f; o1[r] = 0.f; }
    float mref = -1e30f, l = 0.f;
    if (MODE == 3) { mref = sink[head] * LOG2E; l = (hi == 0) ? 1.f : 0.f; }
    v4u kreg, vreg, k2reg = {0u, 0u, 0u, 0u};
#define FA_GLOAD(kt) do { kreg = *(const v4u*)(Ksrc + (size_t)((kt) * 64 + (tid >> 3)) * kp + (tid & 7) * 8); vreg = *(const v4u*)(Vsrc + (size_t)((kt) * 64 + (tid >> 3)) * vp + (tid & 7) * 8); \
        if (MODE == 1 && tid < 256) k2reg = *(const v4u*)(K2src + (size_t)((kt) * 64 + (tid >> 2)) * ZP + (tid & 3) * 8); } while (0)
#define FA_LSTORE(buf) do { *(LAS v4u*)(lds + (buf) * BUF + (tid >> 3) * PK + (tid & 7) * 16) = kreg; *(LAS v4u*)(lds + (buf) * BUF + KBYTES + (tid >> 3) * PV + (tid & 7) * 16) = vreg; \
        if (MODE == 1 && tid < 256) *(LAS v4u*)(lds + (buf) * BUF + (tid >> 2) * PK + 128 + (tid & 3) * 16) = k2reg; } while (0)
    FA_GLOAD(lo); FA_LSTORE(lo & 1);
    __syncthreads();
    for (int kt = lo; kt < hit; ++kt) {
        const bool more = (kt + 1 < hit);
        if (more) FA_GLOAD(kt + 1);
        bool rel = true;
        if (MODE == 0) rel = (kt >= rs && kt < rs + 8);
        if (MODE == 3) rel = (kt * 64 + 63 >= w0 - 128) && (kt * 64 <= w0 + 31 + 128);
        if (rel) {
            const LAS unsigned char* Kb = lds + (kt & 1) * BUF; const LAS unsigned char* Vb = Kb + KBYTES;
            f32x16 p0, p1;
#pragma unroll
            for (int r = 0; r < 16; ++r) { p0[r] = 0.f; p1[r] = 0.f; }
#pragma unroll
            for (int c = 0; c < NC; ++c) {
                const bf16x8_t kA0 = *(const LAS bf16x8_t*)(Kb + r32 * PK + c * 32 + hi * 16);
                const bf16x8_t kA1 = *(const LAS bf16x8_t*)(Kb + (32 + r32) * PK + c * 32 + hi * 16);
                p0 = __builtin_amdgcn_mfma_f32_32x32x16_bf16(kA0, qf[c], p0, 0, 0, 0);
                p1 = __builtin_amdgcn_mfma_f32_32x32x16_bf16(kA1, qf[c], p1, 0, 0, 0);
            }
            float mx = -3e38f;
            if (MODE == 1 || MODE == 2) {
#pragma unroll
                for (int r = 0; r < 16; ++r) mx = fmaxf(mx, fmaxf(p0[r], p1[r]));
                mx *= c2;
            } else if (MODE == 0) {
#pragma unroll
                for (int r = 0; r < 16; ++r) { const int j0 = crow(r, hi), j1 = j0 + 32; const bool v0 = (j0 >= cs0 && j0 < cs0 + 16), v1 = (j1 >= cs0 && j1 < cs0 + 16);
                    const int i0 = v0 ? (kt - rw + 7) * 31 + (j0 - cq + 15) : 0, i1 = v1 ? (kt - rw + 7) * 31 + (j1 - cq + 15) : 0;
                    const float s0 = v0 ? (p0[r] * c2 + Bs[i0]) : -1e30f, s1 = v1 ? (p1[r] * c2 + Bs[i1]) : -1e30f;
                    p0[r] = s0; p1[r] = s1; mx = fmaxf(mx, fmaxf(s0, s1)); }
            } else {
#pragma unroll
                for (int r = 0; r < 16; ++r) { const int d0 = sq - (kt * 64 + crow(r, hi)), d1 = d0 - 32; const bool v0 = (d0 <= 128 && d0 >= -128), v1 = (d1 <= 128 && d1 >= -128);
                    const float s0 = v0 ? p0[r] * c2 : -1e30f, s1 = v1 ? p1[r] * c2 : -1e30f; p0[r] = s0; p1[r] = s1; mx = fmaxf(mx, fmaxf(s0, s1)); }
            }
            mx = fmaxf(mx, __shfl_xor(mx, 32));
            if (__any(mx > mref + THR)) {
                const float mnew = fmaxf(mref, mx); const float alpha = __builtin_amdgcn_exp2f(mref - mnew); mref = mnew; l *= alpha;
                if (hi == 0) wsf[r32] = alpha;
#pragma unroll
                for (int r = 0; r < 16; ++r) { const float a = wsf[crow(r, hi)]; o0[r] *= a; o1[r] *= a; }
            }
            float ps = 0.f;
            if (MODE == 1 || MODE == 2) {
#pragma unroll
                for (int r = 0; r < 16; ++r) { p0[r] = __builtin_amdgcn_exp2f(p0[r] * c2 - mref); p1[r] = __builtin_amdgcn_exp2f(p1[r] * c2 - mref); ps += p0[r] + p1[r]; }
            } else {
#pragma unroll
                for (int r = 0; r < 16; ++r) { p0[r] = __builtin_amdgcn_exp2f(p0[r] - mref); p1[r] = __builtin_amdgcn_exp2f(p1[r] - mref); ps += p0[r] + p1[r]; }
            }
            l += ps;
            v4u pw[4];
            pw[0] = (v4u){cvtpk(p0[0], p0[1]), cvtpk(p0[2], p0[3]), cvtpk(p0[4], p0[5]), cvtpk(p0[6], p0[7])};
            pw[1] = (v4u){cvtpk(p0[8], p0[9]), cvtpk(p0[10], p0[11]), cvtpk(p0[12], p0[13]), cvtpk(p0[14], p0[15])};
            pw[2] = (v4u){cvtpk(p1[0], p1[1]), cvtpk(p1[2], p1[3]), cvtpk(p1[4], p1[5]), cvtpk(p1[6], p1[7])};
            pw[3] = (v4u){cvtpk(p1[8], p1[9]), cvtpk(p1[10], p1[11]), cvtpk(p1[12], p1[13]), cvtpk(p1[14], p1[15])};
            const LAS unsigned char* vbase = Vb + (4 * hi + ((lane & 15) >> 2)) * PV + (16 * ((lane >> 4) & 1) + 4 * (lane & 3)) * 2;
#pragma unroll
            for (int s4 = 0; s4 < 4; ++s4) {
                const bf16x8_t pa = __builtin_bit_cast(bf16x8_t, pw[s4]);
#pragma unroll
                for (int db = 0; db < 2; ++db) {
                    const LAS unsigned char* ad = vbase + (32 * (s4 >> 1) + 16 * (s4 & 1)) * PV + db * 64;
                    const s16x4_t t0 = vtr(ad), t1 = vtr(ad + 8 * PV);
                    const bf16x8_t vB = {t0[0], t0[1], t0[2], t0[3], t1[0], t1[1], t1[2], t1[3]};
                    if (db == 0) o0 = __builtin_amdgcn_mfma_f32_32x32x16_bf16(pa, vB, o0, 0, 0, 0); else o1 = __builtin_amdgcn_mfma_f32_32x32x16_bf16(pa, vB, o1, 0, 0, 0);
                }
            }
        }
        if (more) FA_LSTORE((kt + 1) & 1);
        __syncthreads();
    }
#undef FA_GLOAD
#undef FA_LSTORE
    l += __shfl_xor(l, 32);
    if (hi == 0) wsf[r32] = 1.0f / l;
    bf16* op = MIXp + (tb + w0) * DM + MODE * 256 + head * 64 + r32;
#pragma unroll
    for (int r = 0; r < 16; ++r) { const int row = crow(r, hi); const float il = wsf[row]; op[(size_t)row * DM] = (bf16)f2bf(o0[r] * il); op[(size_t)row * DM + 32] = (bf16)f2bf(o1[r] * il); }
}
__device__ __forceinline__ float gelu_tanh(float x) {
    const float z = 0.7978845608028654f * (x + 0.044715f * x * x * x);
    const float e = __builtin_amdgcn_exp2f(z * (2.0f * LOG2E));
    const float th = 1.0f - 2.0f * __builtin_amdgcn_rcpf(e + 1.0f);
    return 0.5f * x * (1.0f + th);
}
__device__ __forceinline__ void conv_phase(const bf16* U, bf16* Gout  , const float* cw, const float* cb, int gtid, int NGT) {
    constexpr int CG = FF / 8, RC = 16;
    for (int item = gtid; item < (SEQ / RC) * CG; item += NGT) {
        const int cgi = item % CG, rc = item / CG, n = cgi * 8, s0 = rc * RC;
        float wg[3][8], wv[3][8], bg[8], bv[8];
#pragma unroll
        for (int i = 0; i < 3; ++i) {
#pragma unroll
            for (int e = 0; e < 8; e += 4) { const f32x4 a = *(const f32x4*)(cw + (size_t)i * FF2 + n + e), bq = *(const f32x4*)(cw + (size_t)i * FF2 + FF + n + e);
                wg[i][e] = a.x; wg[i][e + 1] = a.y; wg[i][e + 2] = a.z; wg[i][e + 3] = a.w; wv[i][e] = bq.x; wv[i][e + 1] = bq.y; wv[i][e + 2] = bq.z; wv[i][e + 3] = bq.w; } }
#pragma unroll
        for (int e = 0; e < 8; e += 4) { const f32x4 a = *(const f32x4*)(cb + n + e), bq = *(const f32x4*)(cb + FF + n + e);
            bg[e] = a.x; bg[e + 1] = a.y; bg[e + 2] = a.z; bg[e + 3] = a.w; bv[e] = bq.x; bv[e + 1] = bq.y; bv[e + 2] = bq.z; bv[e + 3] = bq.w; }
        float pg[8], pv[8], cgv[8], cv[8], ng[8], nv[8];
        if (s0 > 0) { unpack8(*(const v4u*)(U + (size_t)(s0 - 1) * FF2 + n), pg); unpack8(*(const v4u*)(U + (size_t)(s0 - 1) * FF2 + FF + n), pv); }
        else {
#pragma unroll
            for (int e = 0; e < 8; ++e) { pg[e] = 0.f; pv[e] = 0.f; } }
        unpack8(*(const v4u*)(U + (size_t)s0 * FF2 + n), cgv); unpack8(*(const v4u*)(U + (size_t)s0 * FF2 + FF + n), cv);
        for (int rr = 0; rr < RC; ++rr) {
            const int s = s0 + rr;
            if (s + 1 < SEQ) { unpack8(*(const v4u*)(U + (size_t)(s + 1) * FF2 + n), ng); unpack8(*(const v4u*)(U + (size_t)(s + 1) * FF2 + FF + n), nv); }
            else {
#pragma unroll
                for (int e = 0; e < 8; ++e) { ng[e] = 0.f; nv[e] = 0.f; } }
            float res[8];
#pragma unroll
            for (int e = 0; e < 8; ++e) { const float gate = bg[e] + pg[e] * wg[0][e] + cgv[e] * wg[1][e] + ng[e] * wg[2][e]; const float val = bv[e] + pv[e] * wv[0][e] + cv[e] * wv[1][e] + nv[e] * wv[2][e];
                res[e] = gelu_tanh(gate) * val; }
            v4u w; w.x = pk2(res[0], res[1]); w.y = pk2(res[2], res[3]); w.z = pk2(res[4], res[5]); w.w = pk2(res[6], res[7]);
            *(v4u*)(Gout + (size_t)s * FF + n) = w;
#pragma unroll
            for (int e = 0; e < 8; ++e) { pg[e] = cgv[e]; pv[e] = cv[e]; cgv[e] = ng[e]; cv[e] = nv[e]; }
        }
    }
}

__global__ void __launch_bounds__(512, 2) fwd(Args a) {
    extern __shared__ __attribute__((aligned(16))) unsigned char lds_raw[];
    cg::grid_group grid = cg::this_grid();
    LAS unsigned char* lds = (LAS unsigned char*)lds_raw;
#define PHASE_IDS int tid_ = threadIdx.x; asm volatile("" : "+v"(tid_)); const int tid = tid_, lane = tid & 63, wave = __builtin_amdgcn_readfirstlane(tid >> 6), G = gridDim.x, bx = blockIdx.x; \
    const int gw = bx * 8 + wave, NGW = G * 8, gtid = bx * 512 + tid, NGT = G * 512; (void)lane; (void)gw; (void)NGW; (void)gtid; (void)NGT;
    unsigned char* ws = a.ws;
#define WinT ((bf16*)(ws + WS_WIN))
#define WoutT ((bf16*)(ws + WS_WOUT))
#define WupT ((bf16*)(ws + WS_WUP))
#define WdnT ((bf16*)(ws + WS_WDOWN))
#define WuqT ((bf16*)(ws + WS_WUQ))
#define WukvT ((bf16*)(ws + WS_WUKV))
#define H ((bf16*)(ws + WS_H))
#define Z ((bf16*)(ws + WS_Z))
#define QB ((bf16*)(ws + WS_QB))
#define KVB ((bf16*)(ws + WS_KVB))
#define MIX ((bf16*)(ws + WS_MIX))
#define Y ((float*)(ws + WS_Y))
#define U ((bf16*)(ws + WS_U))
#define Gb ((bf16*)(ws + WS_G))
#define R ((float*)(ws + WS_R))
#define tabF ((const f32x2*)(ws + WS_TABF))
#define tabM ((const f32x2*)(ws + WS_TABM))
#define x0 (a.in[0])
#define out (a.out)


    { PHASE_IDS
    convert_weights(a, 0, ws, lds, gw, NGW, wave, lane, gtid, NGT);
#ifndef NO_TAB
    build_tables(ws, gtid, NGT);
#endif
    for (int t = gw; t < NT; t += NGW) norm_row_to_bf16(x0 + (size_t)t * DM, a.in[1], H + (size_t)t * DM, lane);
    }
    grid.sync();

#pragma unroll 1
    for (int l = 0; l < 2; ++l) {
        { const int G = gridDim.x, bx = blockIdx.x; pg8::Gemm g{H, WinT, NT, ZP, DM, DM, DM}; pg8::StaticOrder S; S.init(NT, ZP, G, bx);
          pg8::EpiBf16<0> E{Z, ZP, nullptr, 0, 0, 1.f};
          pg8::gemm_phase<pg8::EpiBf16<0>, pg8::StaticOrder, true, true>(lds, g, S, E); }
        grid.sync();
#ifndef NO_FIX
        { PHASE_IDS
        for (int t = gw; t < NT; t += NGW) fixup_row(Z + (size_t)t * ZP, t & (SEQ - 1), tabF, tabM, a.in[8] + l * 64, a.in[9] + l * 64, R + (size_t)t * 2, lane); }
#endif
        grid.sync();
        { const int G = gridDim.x, bx = blockIdx.x; pg8::Gemm g{Z + ZB_CQ, WuqT, NT, 512, 256, ZP, 256}; pg8::StaticOrder S; S.init(NT, 512, G, bx);
          pg8::EpiBf16Row E{QB, QP, R, 0};
          pg8::gemm_phase<pg8::EpiBf16Row, pg8::StaticOrder, true, true>(lds, g, S, E); }
        { const int G = gridDim.x, bx = blockIdx.x; pg8::Gemm g{Z + ZB_CKV, WukvT, NT, 512, 128, ZP, 128}; pg8::StaticOrder S; S.init(NT, 512, G, (bx + G / 2) % G);
          pg8::EpiBf16Row E{KVB, QP, R, 1};
          pg8::gemm_phase<pg8::EpiBf16Row, pg8::StaticOrder, true, true>(lds, g, S, E); }
        grid.sync();
#ifndef NO_ATTN
        { PHASE_IDS
        const float* rpb = a.in[3] + (size_t)l * 4 * 465; const float* sink = a.in[10] + l * 4;
        for (int u = bx; u < 1024; u += G) {
            const int kind = u >> 8, v = u & 255, bh = v & 7, b = bh >> 2, head = bh & 3, qblk = v >> 3;
            if (kind == 0) fa_unit<1>(Z, QB, KVB, MIX, tabM, rpb, sink, b, head, qblk, lds, tid);
            else if (kind == 1) fa_unit<2>(Z, QB, KVB, MIX, tabM, rpb, sink, b, head, qblk, lds, tid);
            else if (kind == 2) fa_unit<0>(Z, QB, KVB, MIX, tabM, rpb, sink, b, head, qblk, lds, tid);
            else fa_unit<3>(Z, QB, KVB, MIX, tabM, rpb, sink, b, head, qblk, lds, tid);
            __syncthreads();
        } }
#endif
        grid.sync();
        { const int G = gridDim.x, bx = blockIdx.x; pg8::Gemm g{MIX, WoutT, NT, DM, DM, DM, DM}; pg8::StaticOrder S; S.init(NT, DM, G, bx);
          pg8::EpiF32 E{Y, DM};
          pg8::gemm_phase<pg8::EpiF32, pg8::StaticOrder, true, true>(lds, g, S, E); }
        grid.sync();
        { PHASE_IDS const float* xin = (l == 0) ? x0 : out;
          for (int t = gw; t < NT; t += NGW) resnorm_row(Y + (size_t)t * DM, xin + (size_t)t * DM, a.in[12] + l * DM, out + (size_t)t * DM, a.in[13] + l * DM, H + (size_t)t * DM, lane); }
        grid.sync();
#pragma unroll 1
        for (int hb = 0; hb < 2; ++hb) {
            { const int G = gridDim.x, bx = blockIdx.x; pg8::Gemm g{H + (size_t)hb * SEQ * DM, WupT, SEQ, FF2, DM, DM, DM}; pg8::StaticOrder S; S.init(SEQ, FF2, G, bx);
              pg8::EpiBf16<0> E{U, FF2, nullptr, 0, 0, 1.f};
              pg8::gemm_phase<pg8::EpiBf16<0>, pg8::StaticOrder, true, true>(lds, g, S, E); }
            grid.sync();
#ifndef NO_CONV
            { PHASE_IDS conv_phase(U, Gb + (size_t)hb * SEQ * FF, a.in[15] + (size_t)l * 3 * FF2, a.in[16] + (size_t)l * FF2, gtid, NGT); }
#endif
            grid.sync();
        }
        { const int G = gridDim.x, bx = blockIdx.x; pg8::Gemm g{Gb, WdnT, NT, DM, FF, FF, FF}; pg8::StaticOrder S; S.init(NT, DM, G, bx);
          pg8::EpiF32 E{Y, DM};
          pg8::gemm_phase<pg8::EpiF32, pg8::StaticOrder, true, true>(lds, g, S, E); }
        grid.sync();
        { PHASE_IDS
        for (int t = gw; t < NT; t += NGW) resnorm_row(Y + (size_t)t * DM, out + (size_t)t * DM, a.in[18] + l * DM, out + (size_t)t * DM, a.in[1] + DM, (l == 0) ? H + (size_t)t * DM : nullptr, lane);
        if (l == 0) { convert_weights(a, 1, ws, lds, gw, NGW, wave, lane, gtid, NGT); } }
        if (l == 0) grid.sync();
    }
}

#undef WinT
#undef WoutT
#undef WupT
#undef WdnT
#undef WuqT
#undef WukvT
#undef H
#undef Z
#undef QB
#undef KVB
#undef MIX
#undef Y
#undef U
#undef Gb
#undef R
#undef tabF
#undef tabM
#undef x0
#undef out
extern "C" void kernel_launch(void* const* d_in, const int* in_sizes, int n_in, void* d_out, int out_size, void* d_ws, size_t ws_size, hipStream_t stream) {
    static int grid = 0;
    if (grid == 0) {
        int dev = 0, cus = 0, per_cu = 0;
        hipGetDevice(&dev); hipDeviceGetAttribute(&cus, hipDeviceAttributeMultiprocessorCount, dev);
        hipFuncSetAttribute((const void*)fwd, hipFuncAttributeMaxDynamicSharedMemorySize, LDS_BYTES);
        hipOccupancyMaxActiveBlocksPerMultiprocessor(&per_cu, (const void*)fwd, 512, LDS_BYTES);
        if (per_cu < 1) { fprintf(stderr, "occupancy query says %d blocks/CU\n", per_cu); per_cu = 1; }
        grid = cus;
        if (ws_size < WS_END) { fprintf(stderr, "workspace too small: %zu < %zu\n", ws_size, (size_t)WS_END); grid = -1; }
    }
    if (grid < 0) return;
    Args a{};
    for (int i = 0; i < 19; ++i) a.in[i] = (const float*)d_in[i];
    a.out = (float*)d_out; a.ws = (unsigned char*)d_ws;
    void* args[] = {&a};
    hipError_t e = hipLaunchCooperativeKernel((const void*)fwd, dim3(grid), dim3(512), args, LDS_BYTES, stream);
    if (e != hipSuccess) fprintf(stderr, "cooperative launch failed: %s (grid %d)\n", hipGetErrorString(e), grid);
}
```

```cpp
#include <hip/hip_runtime.h>
#include <hip/hip_cooperative_groups.h>
#include <cstdio>
#include <cstdint>
namespace pg8 {
#define PG8_LAS __attribute__((address_space(3)))
typedef unsigned short bf16_t;
typedef short bf16x8 __attribute__((ext_vector_type(8)));
typedef float f32x4 __attribute__((ext_vector_type(4)));
typedef unsigned u32x4 __attribute__((ext_vector_type(4)));
constexpr int BM = 256, BK = 64, HALF = 128, HTB = HALF * BK * 2  , STAGE_BYTES = 8 * HTB, NXCD = 8, WGM = 8;

__host__ __device__ __forceinline__ int lds_byte(int r, int c) { const int st = (r >> 4) * 2 + (c >> 5), rr = r & 15, cc = c & 31, ob = rr * 64 + cc * 2; return st * 1024 + (ob ^ (((ob >> 9) & 1) << 5)); }
__host__ __device__ __forceinline__ void stage_rc(int b, int& R, int& C) { const int st = b / 1024, sb = b % 1024, swz = sb ^ (((sb >> 9) & 1) << 5); R = (st >> 1) * 16 + swz / 64; C = (st & 1) * 32 + (swz % 64) / 2; }
__host__ __device__ __forceinline__ int perm32(int rho) { const int n = rho >> 4, i = rho & 15; return 8 * (i >> 2) + 4 * n + (i & 3); }

struct Unit { int pm, pn; };
struct Gemm { const bf16_t* A; const bf16_t* Bt; int M, N, K, lda, ldb; };

struct StaticOrder {
    int nM, nN, nwg, G, c;
    __host__ __device__ void init(int M, int N, int G_, int c_) { nM = M / BM; nN = N / BM; nwg = nM * nN; G = G_; c = c_; }
    __host__ __device__ bool next(int i, Unit& u) const {
        const long L = (long)i * G + c; if (L >= nwg) return false;
        int wgid = (int)L; { const int q = nwg / NXCD, r = nwg % NXCD, xcd = wgid % NXCD, off = wgid / NXCD; wgid = (xcd < r ? xcd * (q + 1) : r * (q + 1) + (xcd - r) * q) + off; }
        const int nig = WGM * nN, gid = wgid / nig, fm = gid * WGM, gsz = (nM - fm) < WGM ? (nM - fm) : WGM;
        u.pm = fm + ((wgid % nig) % gsz); u.pn = (wgid % nig) / gsz; return true;
    }
    __device__ __forceinline__ void a_ready(const Unit&) const {}
    __device__ __forceinline__ void done(const Unit&) const {}
};

__device__ __forceinline__ unsigned cvt_pk_bf16(float lo, float hi) { unsigned r; asm volatile("v_cvt_pk_bf16_f32 %0, %1, %2" : "=v"(r) : "v"(lo), "v"(hi)); return r; }
typedef float f32x2 __attribute__((ext_vector_type(2)));
__device__ __forceinline__ f32x2 gelu_pk(f32x2 v) {
    const f32x2 av = __builtin_elementwise_abs(v), d = av * 0.2316418882f + 1.0f;
    f32x2 t; t.x = __builtin_amdgcn_rcpf(d.x); t.y = __builtin_amdgcn_rcpf(d.y);
    f32x2 q = t * 0.5307027145f + (-0.7265760135f); q = q * t + 0.7107068705f; q = q * t + (-0.142248368f); q = q * t + 0.127414796f; q = q * t;
    const f32x2 s = (v * v) * (-0.72134752044f);
    f32x2 e; e.x = __builtin_amdgcn_exp2f(s.x); e.y = __builtin_amdgcn_exp2f(s.y);
    const f32x2 m = v * (q * e), r = v - m;
    f32x2 o; o.x = v.x < 0.f ? m.x : r.x; o.y = v.y < 0.f ? m.y : r.y; return o;
}

template <int ACT  > struct EpiBf16 {
    static constexpr bool PERM = true, AFTER_DRAIN = false; static_assert(ACT == 0 || ACT == 1, "EpiBf16: ACT is 0 (none) or 1 (gelu_pk)");
    bf16_t* O; int ldc; const float* bias; int split_cols; size_t split_stride; float scale0;
    __device__ __forceinline__ void operator()(const f32x4 (&acc)[2][2][4][2], const Unit& u, int wr, int wc, int fr, int fq) const {
        const int row0 = u.pm * BM + wr * 64 + fr; int colt = u.pn * BM; bf16_t* base = O;
        float sc = 1.f; if (split_cols) { const int t = colt / split_cols; base += (size_t)t * split_stride; colt -= t * split_cols; if (t == 0) sc = scale0; }
        const int col0 = colt + wc * 32 + 8 * fq, bcol0 = u.pn * BM + wc * 32 + 8 * fq;
        f32x4 bv[2][2];
#pragma unroll
        for (int bj = 0; bj < 2; ++bj)
#pragma unroll
            for (int n = 0; n < 2; ++n) bv[bj][n] = bias ? *(const f32x4*)(bias + bcol0 + bj * HALF + 4 * n) : (f32x4){0.f, 0.f, 0.f, 0.f};
#pragma unroll
        for (int ai = 0; ai < 2; ++ai)
#pragma unroll
            for (int m = 0; m < 4; ++m) { bf16_t* rowp = base + (size_t)(row0 + ai * HALF + m * 16) * ldc + col0;
#pragma unroll
                for (int bj = 0; bj < 2; ++bj) { f32x4 v0 = acc[ai][bj][m][0] + bv[bj][0], v1 = acc[ai][bj][m][1] + bv[bj][1];
                    if (ACT == 1) { f32x2 a = gelu_pk((f32x2){v0[0], v0[1]}), b = gelu_pk((f32x2){v0[2], v0[3]}), c = gelu_pk((f32x2){v1[0], v1[1]}), d = gelu_pk((f32x2){v1[2], v1[3]});
                        v0 = (f32x4){a.x, a.y, b.x, b.y}; v1 = (f32x4){c.x, c.y, d.x, d.y}; }
                    v0 = v0 * sc; v1 = v1 * sc; u32x4 w; w.x = cvt_pk_bf16(v0[0], v0[1]); w.y = cvt_pk_bf16(v0[2], v0[3]); w.z = cvt_pk_bf16(v1[0], v1[1]); w.w = cvt_pk_bf16(v1[2], v1[3]);
                    *(u32x4*)(rowp + bj * HALF) = w; } }
    }
};

struct PanelStats {
    unsigned* xbuf;
    unsigned* cnt;
    unsigned* tmo;
    int ntn; float eps;
    unsigned code;
    __device__ __forceinline__ bool run(const f32x4 (&v)[2][2][4][2], const Unit& u, int wr, int wc, int fr, int fq, PG8_LAS unsigned char* lds, int wid, int lane) const {
        typedef float f32x2v __attribute__((ext_vector_type(2)));
        PG8_LAS f32x2v* P = (PG8_LAS f32x2v*)lds;
        PG8_LAS f32x2v* S = (PG8_LAS f32x2v*)(lds + 8192);
        PG8_LAS unsigned* flag = (PG8_LAS unsigned*)(lds + 8192 + 2048);
#pragma unroll
        for (int ai = 0; ai < 2; ++ai)
#pragma unroll
            for (int m = 0; m < 4; ++m) {
                float s = 0.f;
#pragma unroll
                for (int bj = 0; bj < 2; ++bj)
#pragma unroll
                    for (int n = 0; n < 2; ++n) { const f32x4 x = v[ai][bj][m][n]; s += (x[0] + x[1]) + (x[2] + x[3]); }
                s += __shfl_xor(s, 16); s += __shfl_xor(s, 32);
                const float mw = s * (1.0f / 64.0f); float q = 0.f;
#pragma unroll
                for (int bj = 0; bj < 2; ++bj)
#pragma unroll
                    for (int n = 0; n < 2; ++n) { const f32x4 d = v[ai][bj][m][n] - mw; q += (d[0] * d[0] + d[1] * d[1]) + (d[2] * d[2] + d[3] * d[3]); }
                q += __shfl_xor(q, 16); q += __shfl_xor(q, 32);
                if (fq == 0) P[(ai * HALF + wr * 64 + m * 16 + fr) * 4 + wc] = (f32x2v){mw, q};
            }
        asm volatile("s_waitcnt lgkmcnt(0)" ::: "memory"); __builtin_amdgcn_s_barrier(); asm volatile("" ::: "memory");
#if defined(BROKEN_EXCHANGE_NO_WAIT)
#warning BROKEN CONTROL BUILD: the row-statistics exchange does not wait; results are wrong by design
        if (blockIdx.x >= 64) { const long long t0_ = clock64(); while (clock64() - t0_ < 60000) __builtin_amdgcn_s_sleep(8); }
#endif
        const int row = wid * 32 + (lane & 31);
        if (lane < 32) {
            const f32x2v a = P[row * 4 + 0], b = P[row * 4 + 1], c = P[row * 4 + 2], d = P[row * 4 + 3];
            const float mt = (a.x + b.x + c.x + d.x) * 0.25f;
            const float da = a.x - mt, db = b.x - mt, dc = c.x - mt, dd = d.x - mt;
            const float m2 = (a.y + b.y) + (c.y + d.y) + 64.0f * ((da * da + db * db) + (dc * dc + dd * dd));
            unsigned long long* slot = (unsigned long long*)xbuf + ((size_t)(u.pm * BM + row) * 4 + u.pn);
            __hip_atomic_store(slot, ((unsigned long long)__float_as_uint(m2) << 32) | __float_as_uint(mt), __ATOMIC_RELAXED, __HIP_MEMORY_SCOPE_AGENT);
        }
        asm volatile("s_waitcnt vmcnt(0)" ::: "memory");
        if (lane == 0) __hip_atomic_fetch_add(cnt + 64 * u.pm, 1u, __ATOMIC_RELAXED, __HIP_MEMORY_SCOPE_AGENT);
        if (wid == 0) {
            bool dead = false; const unsigned long long t0 = __builtin_amdgcn_s_memrealtime(); const unsigned want = 8u * (unsigned)ntn;
            for (;;) {
#if defined(BROKEN_EXCHANGE_NO_WAIT)
                break;
#endif
                if ((unsigned)__builtin_amdgcn_readfirstlane(__hip_atomic_load(cnt + 64 * u.pm, __ATOMIC_RELAXED, __HIP_MEMORY_SCOPE_AGENT)) >= want) break;
                if (__builtin_amdgcn_s_memrealtime() - t0 > 2000000ull) {
                    if (lane == 0) { unsigned expect = 0u; __hip_atomic_compare_exchange_strong(tmo + 1, &expect, code | (unsigned)(u.pm & 0xff), __ATOMIC_RELAXED, __ATOMIC_RELAXED, __HIP_MEMORY_SCOPE_AGENT);
                                     __hip_atomic_store(tmo, 1u, __ATOMIC_RELAXED, __HIP_MEMORY_SCOPE_AGENT); }
                    dead = true; break; }
                __builtin_amdgcn_s_sleep(2);
            }
            __builtin_amdgcn_fence(__ATOMIC_ACQUIRE, "agent");
            if (lane == 0) flag[0] = dead ? 1u : 0u;
        }
        asm volatile("s_waitcnt vmcnt(0) lgkmcnt(0)" ::: "memory"); __builtin_amdgcn_s_barrier(); asm volatile("" ::: "memory");
        const bool bad = flag[0] != 0u;
        if (lane < 32) {
            const unsigned long long* slot = (const unsigned long long*)xbuf + (size_t)(u.pm * BM + row) * 4; float mt[4], m2[4]; float ms = 0.f;
#pragma unroll
            for (int t = 0; t < 4; ++t) { if (t < ntn) { const unsigned long long w = __hip_atomic_load(slot + t, __ATOMIC_RELAXED, __HIP_MEMORY_SCOPE_AGENT); mt[t] = __uint_as_float((unsigned)w); m2[t] = __uint_as_float((unsigned)(w >> 32)); } else { mt[t] = 0.f; m2[t] = 0.f; } ms += mt[t]; }
            const float mean = ms / (float)ntn; float q = 0.f;
#pragma unroll
            for (int t = 0; t < 4; ++t) if (t < ntn) { const float dm = mt[t] - mean; q += m2[t] + 256.0f * dm * dm; }
            S[row] = (f32x2v){mean, 1.0f / sqrtf(q / (256.0f * (float)ntn) + eps)};
        }
        asm volatile("s_waitcnt lgkmcnt(0)" ::: "memory"); __builtin_amdgcn_s_barrier(); asm volatile("" ::: "memory");
        return bad;
    }
};
struct EpiLnRes {
    static constexpr bool PERM = false, AFTER_DRAIN = true;
    const float* base; float* out; int ldc; const float* bias; PanelStats st; unsigned poison;
    __device__ __forceinline__ void fused(f32x4 (&acc)[2][2][4][2], const Unit& u, int wr, int wc, int fr, int fq, PG8_LAS unsigned char* lds, int wid, int lane) const {
        typedef float f32x2v __attribute__((ext_vector_type(2)));
        const PG8_LAS f32x2v* S = (const PG8_LAS f32x2v*)(lds + 8192);
        const int col0 = u.pn * BM + wc * 32 + 4 * fq;
#pragma unroll
        for (int bj = 0; bj < 2; ++bj)
#pragma unroll
            for (int n = 0; n < 2; ++n) { const f32x4 bv = bias ? *(const f32x4*)(bias + col0 + bj * HALF + n * 16) : (f32x4){0.f, 0.f, 0.f, 0.f};
#pragma unroll
                for (int ai = 0; ai < 2; ++ai)
#pragma unroll
                    for (int m = 0; m < 4; ++m) acc[ai][bj][m][n] += bv; }
        f32x4 pre[4][2][2];
#pragma unroll
        for (int m = 0; m < 4; ++m) { const size_t off = (size_t)(u.pm * BM + wr * 64 + m * 16 + fr) * ldc + col0;
#pragma unroll
            for (int bj = 0; bj < 2; ++bj)
#pragma unroll
                for (int n = 0; n < 2; ++n) pre[m][bj][n] = *(const f32x4*)(base + off + bj * HALF + n * 16); }
        const bool bad = st.run(acc, u, wr, wc, fr, fq, lds, wid, lane) || poison != 0u;
        const float qnan = __builtin_nanf("");
#pragma unroll
        for (int ai = 0; ai < 2; ++ai)
#pragma unroll
            for (int m = 0; m < 4; ++m) { const int r = ai * HALF + wr * 64 + m * 16 + fr; const f32x2v sr = S[r]; const size_t off = (size_t)(u.pm * BM + r) * ldc + col0;
#pragma unroll
                for (int bj = 0; bj < 2; ++bj)
#pragma unroll
                    for (int n = 0; n < 2; ++n) { const f32x4 bs = ai == 0 ? pre[m][bj][n] : *(const f32x4*)(base + off + bj * HALF + n * 16); f32x4 o = bs + (acc[ai][bj][m][n] - sr.x) * sr.y;
                        if (bad) o = (f32x4){qnan, qnan, qnan, qnan}; *(f32x4*)(out + off + bj * HALF + n * 16) = o; }
                if (m & 1) asm volatile("" ::: "memory"); }
    }
};
struct EpiLnResLn {
    static constexpr bool PERM = false, AFTER_DRAIN = true;
    const float* base; float* out; bf16_t* xn; int ldc; const float* bias; PanelStats st1, st2; unsigned poison;
    __device__ __forceinline__ void fused(f32x4 (&acc)[2][2][4][2], const Unit& u, int wr, int wc, int fr, int fq, PG8_LAS unsigned char* lds, int wid, int lane) const {
        typedef float f32x2v __attribute__((ext_vector_type(2))); typedef unsigned u32x2v __attribute__((ext_vector_type(2)));
        const PG8_LAS f32x2v* S = (const PG8_LAS f32x2v*)(lds + 8192);
        const int col0 = u.pn * BM + wc * 32 + 4 * fq;
#pragma unroll
        for (int bj = 0; bj < 2; ++bj)
#pragma unroll
            for (int n = 0; n < 2; ++n) { const f32x4 bv = bias ? *(const f32x4*)(bias + col0 + bj * HALF + n * 16) : (f32x4){0.f, 0.f, 0.f, 0.f};
#pragma unroll
                for (int ai = 0; ai < 2; ++ai)
#pragma unroll
                    for (int m = 0; m < 4; ++m) acc[ai][bj][m][n] += bv; }
        bool bad = st1.run(acc, u, wr, wc, fr, fq, lds, wid, lane) || poison != 0u;
        const float qnan = __builtin_nanf("");
#pragma unroll
        for (int ai = 0; ai < 2; ++ai)
#pragma unroll
            for (int m = 0; m < 4; ++m) { const int r = ai * HALF + wr * 64 + m * 16 + fr; const f32x2v sr = S[r]; const size_t off = (size_t)(u.pm * BM + r) * ldc + col0;
#pragma unroll
                for (int bj = 0; bj < 2; ++bj)
#pragma unroll
                    for (int n = 0; n < 2; ++n) { const f32x4 bs = *(const f32x4*)(base + off + bj * HALF + n * 16); acc[ai][bj][m][n] = bs + (acc[ai][bj][m][n] - sr.x) * sr.y; }
                asm volatile("" : "+v"(acc[ai][0][m][0]), "+v"(acc[ai][0][m][1]), "+v"(acc[ai][1][m][0]), "+v"(acc[ai][1][m][1]));
                if (m & 1) asm volatile("" ::: "memory"); }
        const bool bad1 = bad;
        bad = st2.run(acc, u, wr, wc, fr, fq, lds, wid, lane) || bad;
#pragma unroll
        for (int ai = 0; ai < 2; ++ai)
#pragma unroll
            for (int m = 0; m < 4; ++m) { const int r = ai * HALF + wr * 64 + m * 16 + fr; const f32x2v sr = S[r]; const size_t off = (size_t)(u.pm * BM + r) * ldc + col0;
#pragma unroll
                for (int bj = 0; bj < 2; ++bj)
#pragma unroll
                    for (int n = 0; n < 2; ++n) { const f32x4 x1 = acc[ai][bj][m][n]; *(f32x4*)(out + off + bj * HALF + n * 16) = bad1 ? (f32x4){qnan, qnan, qnan, qnan} : x1;
                        const f32x4 o = (x1 - sr.x) * sr.y; u32x2v w; w.x = cvt_pk_bf16(o[0], o[1]); w.y = cvt_pk_bf16(o[2], o[3]);
                        if (bad) { w.x = 0x7fc07fc0u; w.y = 0x7fc07fc0u; } *(u32x2v*)(xn + off + bj * HALF + n * 16) = w; }
                asm volatile("" ::: "memory"); }
    }
};

template <class Epi, class Sched, bool ALIGN_EPI = false, bool SP2 = false>
__device__ __forceinline__ void gemm_phase(PG8_LAS unsigned char* lds, const Gemm g, const Sched& S, const Epi& E) {
    int tid_ = threadIdx.x; asm volatile("" : "+v"(tid_));
    const int tid = tid_, wid = __builtin_amdgcn_readfirstlane(tid >> 6), lane = tid & 63, wr = wid >> 2, wc = wid & 3, fr = lane & 15, fq = lane >> 4;
    int K_ = g.K, lda_ = g.lda, ldb_ = g.ldb; asm volatile("" : "+s"(K_), "+s"(lda_), "+s"(ldb_));
    const int K = K_, nt = K / BK;
    unsigned voffA[2], voffB[2];
#pragma unroll
    for (int i = 0; i < 2; ++i) { int R, C; stage_rc(tid * 16 + i * 8192, R, C); const int Rb = Epi::PERM ? ((R & ~31) + perm32(R & 31)) : R;
        voffA[i] = (unsigned)(R * lda_ + C) * 2u; voffB[i] = (unsigned)(Rb * ldb_ + C) * 2u; }
    const size_t kstep = (size_t)(BK * 2);
    const size_t hstepA = (size_t)HALF * lda_ * 2, hstepB = (size_t)HALF * ldb_ * 2;
    const size_t tstepA = 2 * hstepA, tstepB = 2 * hstepB;
    const unsigned ldsw = (unsigned)wid * 1024u;
    const int aoff = lds_byte(wr * 64 + fr, fq * 8), boff = lds_byte(wc * 32 + fr, fq * 8);
#define PG8_SA(b, h) (((b) * 2 + (h)) * HTB)
#define PG8_SB(b, h) ((4 + (b) * 2 + (h)) * HTB)
#define PG8_STAGE(bufoff, gbase, voff) do { _Pragma("unroll") for (int _i = 0; _i < 2; ++_i) \
        __builtin_amdgcn_global_load_lds((const unsigned*)((const char*)(gbase) + (voff)[_i]), (PG8_LAS unsigned*)(lds + (bufoff) + ldsw + _i * 8192), 16, 0, 0); } while (0)
#define PG8_LDA(dst, b, h) do { _Pragma("unroll") for (int m = 0; m < 4; ++m) _Pragma("unroll") for (int k = 0; k < 2; ++k) dst[m][k] = *(const PG8_LAS bf16x8*)(lds + PG8_SA(b, h) + aoff + m * 2048 + k * 1024); } while (0)
#define PG8_LDB(dst, b, h) do { _Pragma("unroll") for (int n = 0; n < 2; ++n) _Pragma("unroll") for (int k = 0; k < 2; ++k) dst[n][k] = *(const PG8_LAS bf16x8*)(lds + PG8_SB(b, h) + boff + n * 2048 + k * 1024); } while (0)
#define PG8_MMA(ai, bj, At, Bt) do { __builtin_amdgcn_s_setprio(1); _Pragma("unroll") for (int m = 0; m < 4; ++m) _Pragma("unroll") for (int n = 0; n < 2; ++n) _Pragma("unroll") for (int k = 0; k < 2; ++k) \
        acc[ai][bj][m][n] = __builtin_amdgcn_mfma_f32_16x16x32_bf16(Bt[n][k], At[m][k], acc[ai][bj][m][n], 0, 0, 0); __builtin_amdgcn_s_setprio(0); } while (0)
#define PG8_WAIT_V(n) asm volatile("s_waitcnt vmcnt(" #n ")" ::: "memory")
#define PG8_WAIT_L(n) asm volatile("s_waitcnt lgkmcnt(" #n ")" ::: "memory")
#define PG8_BAR __builtin_amdgcn_s_barrier()
#define PG8_SCHED __builtin_amdgcn_sched_barrier(0)
    Unit cur, nxt; int ui = 0;
    if (!S.next(0, cur)) return;
    f32x4 acc[2][2][4][2];
#pragma unroll
    for (int a = 0; a < 2; ++a)
#pragma unroll
        for (int b = 0; b < 2; ++b)
#pragma unroll
            for (int m = 0; m < 4; ++m)
#pragma unroll
                for (int n = 0; n < 2; ++n) acc[a][b][m][n] = (f32x4){0.f, 0.f, 0.f, 0.f};
    bf16x8 At[4][2], B0[2][2], B1[2][2];
    const char* cA = (const char*)g.A + (size_t)cur.pm * tstepA; const char* cB = (const char*)g.Bt + (size_t)cur.pn * tstepB;
    S.a_ready(cur);
    if constexpr (SP2) {
        PG8_STAGE(PG8_SB(0, 0), cB, voffB); PG8_STAGE(PG8_SB(0, 1), cB + hstepB, voffB); PG8_STAGE(PG8_SA(0, 0), cA, voffA); PG8_STAGE(PG8_SA(0, 1), cA + hstepA, voffA);
        if (wr == 1) PG8_BAR;
        PG8_WAIT_V(2); PG8_BAR;
        PG8_STAGE(PG8_SB(1, 0), cB + kstep, voffB); PG8_STAGE(PG8_SA(1, 0), cA + kstep, voffA); PG8_STAGE(PG8_SB(1, 1), cB + hstepB + kstep, voffB);
        PG8_WAIT_V(6); PG8_BAR;
    } else {
        PG8_STAGE(PG8_SB(0, 0), cB, voffB); PG8_STAGE(PG8_SA(0, 0), cA, voffA); PG8_STAGE(PG8_SB(0, 1), cB + hstepB, voffB); PG8_STAGE(PG8_SA(0, 1), cA + hstepA, voffA);
        if (wr == 1) PG8_BAR;
        PG8_WAIT_V(4); PG8_BAR;
        PG8_STAGE(PG8_SB(1, 0), cB + kstep, voffB); PG8_STAGE(PG8_SA(1, 0), cA + kstep, voffA); PG8_STAGE(PG8_SB(1, 1), cB + hstepB + kstep, voffB);
        PG8_WAIT_V(6); PG8_BAR;
    }
    for (;;) {
        const bool has_next = S.next(ui + 1, nxt);
        const char* nA = has_next ? (const char*)g.A + (size_t)nxt.pm * tstepA : cA; const char* nB = has_next ? (const char*)g.Bt + (size_t)nxt.pn * tstepB : cB;
        for (int t = 0; t < nt; t += 2) {
            const bool last = (t == nt - 2);
            const char* a1 = cA + (size_t)(t + 1) * kstep;
            const char* a2 = last ? nA : cA + (size_t)(t + 2) * kstep; const char* b2 = last ? nB : cB + (size_t)(t + 2) * kstep;
            const char* a3 = a2 + kstep; const char* b3 = b2 + kstep;
            if (last && has_next) S.a_ready(nxt);
            if constexpr (SP2) {
            PG8_LDB(B0, 0, 0); PG8_LDB(B1, 0, 1); PG8_SCHED; PG8_LDA(At, 0, 0); PG8_STAGE(PG8_SA(1, 1), a1 + hstepA, voffA);
            PG8_WAIT_V(8); PG8_WAIT_L(0); PG8_BAR; PG8_MMA(0, 0, At, B0); PG8_MMA(0, 1, At, B1); PG8_BAR; PG8_SCHED;
            PG8_LDA(At, 0, 1); PG8_STAGE(PG8_SB(0, 0), b2, voffB); PG8_STAGE(PG8_SB(0, 1), b2 + hstepB, voffB); PG8_STAGE(PG8_SA(0, 0), a2, voffA);
            PG8_WAIT_V(8); PG8_WAIT_L(0); PG8_BAR; PG8_MMA(1, 0, At, B0); PG8_MMA(1, 1, At, B1); PG8_BAR; PG8_SCHED;
            PG8_LDB(B0, 1, 0); PG8_LDB(B1, 1, 1); PG8_SCHED; PG8_LDA(At, 1, 0); PG8_STAGE(PG8_SA(0, 1), a2 + hstepA, voffA);
            PG8_WAIT_V(8); PG8_WAIT_L(0); PG8_BAR; PG8_MMA(0, 0, At, B0); PG8_MMA(0, 1, At, B1); PG8_BAR; PG8_SCHED;
            PG8_LDA(At, 1, 1); PG8_STAGE(PG8_SB(1, 0), b3, voffB); PG8_STAGE(PG8_SB(1, 1), b3 + hstepB, voffB); PG8_STAGE(PG8_SA(1, 0), a3, voffA);
            PG8_WAIT_V(8); PG8_WAIT_L(0); PG8_BAR; PG8_MMA(1, 0, At, B0); PG8_MMA(1, 1, At, B1); PG8_BAR; PG8_SCHED;
            } else {
            PG8_LDB(B0, 0, 0); PG8_SCHED; PG8_LDA(At, 0, 0); PG8_STAGE(PG8_SA(1, 1), a1 + hstepA, voffA);
            PG8_WAIT_L(8); PG8_BAR; PG8_WAIT_L(0); PG8_MMA(0, 0, At, B0); PG8_BAR; PG8_SCHED;
            PG8_LDB(B1, 0, 1); PG8_STAGE(PG8_SB(0, 0), b2, voffB);
            PG8_BAR; PG8_WAIT_L(0); PG8_MMA(0, 1, At, B1); PG8_BAR;
            PG8_LDA(At, 0, 1); PG8_STAGE(PG8_SA(0, 0), a2, voffA);
            PG8_BAR; PG8_WAIT_L(0); PG8_MMA(1, 0, At, B0); PG8_BAR; PG8_SCHED;
            PG8_STAGE(PG8_SB(0, 1), b2 + hstepB, voffB);
            PG8_WAIT_V(6); PG8_BAR; PG8_MMA(1, 1, At, B1); PG8_BAR;
            PG8_LDB(B0, 1, 0); PG8_SCHED; PG8_LDA(At, 1, 0); PG8_STAGE(PG8_SA(0, 1), a2 + hstepA, voffA);
            PG8_WAIT_L(8); PG8_BAR; PG8_WAIT_L(0); PG8_MMA(0, 0, At, B0); PG8_BAR; PG8_SCHED;
            PG8_LDB(B1, 1, 1); PG8_STAGE(PG8_SB(1, 0), b3, voffB);
            PG8_BAR; PG8_WAIT_L(0); PG8_MMA(0, 1, At, B1); PG8_BAR;
            PG8_LDA(At, 1, 1); PG8_STAGE(PG8_SA(1, 0), a3, voffA);
            PG8_BAR; PG8_WAIT_L(0); PG8_MMA(1, 0, At, B0); PG8_BAR; PG8_SCHED;
            PG8_STAGE(PG8_SB(1, 1), b3 + hstepB, voffB);
            PG8_WAIT_V(6); PG8_BAR; PG8_MMA(1, 1, At, B1); PG8_BAR;
            }
        }
        if constexpr (ALIGN_EPI) { if (wr == 0) PG8_BAR; }
        if constexpr (!Epi::AFTER_DRAIN) { E(acc, cur, wr, wc, fr, fq); S.done(cur); }
        if (!has_next) break;
#pragma unroll
        for (int a = 0; a < 2; ++a)
#pragma unroll
            for (int b = 0; b < 2; ++b)
#pragma unroll
                for (int m = 0; m < 4; ++m)
#pragma unroll
                    for (int n = 0; n < 2; ++n) acc[a][b][m][n] = (f32x4){0.f, 0.f, 0.f, 0.f};
        cur = nxt; cA = nA; cB = nB; ++ui;
        if constexpr (ALIGN_EPI) { if (wr == 1) PG8_BAR; }
    }
    PG8_WAIT_V(0);
    if constexpr (!ALIGN_EPI) { if (wr == 0) PG8_BAR; }
    PG8_BAR;
    if constexpr (Epi::AFTER_DRAIN) { E.fused(acc, cur, wr, wc, fr, fq, lds, wid, lane); S.done(cur); }
#undef PG8_SA
#undef PG8_SB
#undef PG8_STAGE
#undef PG8_LDA
#undef PG8_LDB
#undef PG8_MMA
#undef PG8_WAIT_V
#undef PG8_WAIT_L
#undef PG8_BAR
#undef PG8_SCHED
}
}
namespace pg8 {
struct EpiF32 {
    static constexpr bool PERM = false, AFTER_DRAIN = false;
    float* O; int ldc;
    __device__ __forceinline__ void operator()(const f32x4 (&acc)[2][2][4][2], const Unit& u, int wr, int wc, int fr, int fq) const {
        const int row0 = u.pm * BM + wr * 64 + fr, col0 = u.pn * BM + wc * 32 + 4 * fq;
#pragma unroll
        for (int ai = 0; ai < 2; ++ai)
#pragma unroll
            for (int m = 0; m < 4; ++m) { float* rowp = O + (size_t)(row0 + ai * HALF + m * 16) * ldc + col0;
#pragma unroll
                for (int bj = 0; bj < 2; ++bj)
#pragma unroll
                    for (int n = 0; n < 2; ++n) *(f32x4*)(rowp + bj * HALF + n * 16) = acc[ai][bj][m][n]; }
    }
};
struct EpiBf16Row {
    static constexpr bool PERM = true, AFTER_DRAIN = false;
    bf16_t* O; int ldc; const float* R; int ridx;
    __device__ __forceinline__ void operator()(const f32x4 (&acc)[2][2][4][2], const Unit& u, int wr, int wc, int fr, int fq) const {
        const int row0 = u.pm * BM + wr * 64 + fr, col0 = u.pn * BM + wc * 32 + 8 * fq;
#pragma unroll
        for (int ai = 0; ai < 2; ++ai)
#pragma unroll
            for (int m = 0; m < 4; ++m) { const int r = row0 + ai * HALF + m * 16; const float sc = R[(size_t)r * 2 + ridx]; bf16_t* rowp = O + (size_t)r * ldc + col0;
#pragma unroll
                for (int bj = 0; bj < 2; ++bj) { const f32x4 v0 = acc[ai][bj][m][0] * sc, v1 = acc[ai][bj][m][1] * sc;
                    u32x4 w; w.x = cvt_pk_bf16(v0[0], v0[1]); w.y = cvt_pk_bf16(v0[2], v0[3]); w.z = cvt_pk_bf16(v1[0], v1[1]); w.w = cvt_pk_bf16(v1[2], v1[3]);
                    *(u32x4*)(rowp + bj * HALF) = w; } }
    }
};
}

namespace cg = cooperative_groups;
#define LAS __attribute__((address_space(3)))
typedef unsigned short bf16;
typedef unsigned v4u __attribute__((ext_vector_type(4)));
typedef unsigned v2u __attribute__((ext_vector_type(2)));
typedef float f32x4 __attribute__((ext_vector_type(4)));
typedef float f32x2 __attribute__((ext_vector_type(2)));

constexpr int NT = 16384, SEQ = 8192, DM = 1024, ZP = 2304, QP = 512, FF = 2816, FF2 = 5632, NCOLS = 2208;
constexpr float EPS = 1e-6f;
constexpr float LOG2E = 1.4426950408889634f;
constexpr int ZA_Q = 0, ZA_K = 256, ZA_V = 512, ZB_CQ = 768, ZB_CKV = 1024, ZB_KR = 1152, ZC_Q = 1184, ZC_K = 1440, ZC_V = 1568, ZD_Q = 1696, ZD_K = 1952, ZD_V = 2080;
constexpr size_t MiB = 1u << 20;
constexpr size_t WS_TABF = 0, WS_TABM = 2 * MiB, WS_R = 3 * MiB, WS_BAR = 3 * MiB + 512 * 1024;
constexpr size_t WS_WIN = 4 * MiB, WS_WOUT = 9 * MiB, WS_WUP = 11 * MiB, WS_WDOWN = 22 * MiB, WS_WUQ = 28 * MiB, WS_WUKV = 28 * MiB + 512 * 1024;
constexpr size_t WS_H = 29 * MiB, WS_BIG = 61 * MiB;
constexpr size_t WS_Z = WS_BIG, WS_QB = WS_BIG + 72 * MiB, WS_KVB = WS_QB + 16 * MiB, WS_MIX = WS_KVB + 16 * MiB, WS_Y = WS_BIG;
constexpr size_t WS_U = WS_BIG, WS_G = WS_BIG + 88 * MiB, WS_END = WS_G + 88 * MiB;
static_assert(WS_END <= 256 * MiB, "ws");
constexpr int LDS_BYTES = 147456;

struct Args { const float* in[19]; float* out; unsigned char* ws; };

__device__ __forceinline__ unsigned f2bf(float f) { unsigned u = __builtin_bit_cast(unsigned, f); return (u + 0x7fffu + ((u >> 16) & 1u)) >> 16; }
__device__ __forceinline__ unsigned pk2(float lo, float hi) { return f2bf(lo) | (f2bf(hi) << 16); }
__device__ __forceinline__ float bf2f(unsigned b) { return __uint_as_float(b << 16); }
__device__ __forceinline__ float bflo(unsigned w) { return __uint_as_float(w << 16); }
__device__ __forceinline__ float bfhi(unsigned w) { return __uint_as_float(w & 0xffff0000u); }
__device__ __forceinline__ float wave_sum(float v) {
#pragma unroll
    for (int o = 1; o < 64; o <<= 1) v += __shfl_xor(v, o);
    return v;
}
#define LDS_WAIT() asm volatile("s_waitcnt lgkmcnt(0)" ::: "memory")

__device__ __forceinline__ void transpose_item(const float* W, int K, int N, bf16* WT, const float* kscale, LAS float* scr, int item, int lane) {
    const int nblk = N / 32, kb = item / nblk, nb = item % nblk, k0 = 64 * kb, n0 = 32 * nb;
#pragma unroll 8
    for (int i = 0; i < 32; ++i) { const int kk = 2 * i + (lane >> 5); float w = W[(size_t)(k0 + kk) * N + n0 + (lane & 31)]; if (kscale) w *= kscale[k0 + kk]; scr[kk * 33 + (lane & 31)] = w; }
    LDS_WAIT(); asm volatile("" ::: "memory");
    const int c = lane & 7;
#pragma unroll
    for (int j = 0; j < 4; ++j) { const int n = (lane >> 3) + 8 * j; const LAS float* s = scr + (8 * c) * 33 + n;
        v4u o; o.x = pk2(s[0 * 33], s[1 * 33]); o.y = pk2(s[2 * 33], s[3 * 33]); o.z = pk2(s[4 * 33], s[5 * 33]); o.w = pk2(s[6 * 33], s[7 * 33]);
        *(v4u*)(WT + (size_t)(n0 + n) * K + k0 + 8 * c) = o; }
    LDS_WAIT(); asm volatile("" ::: "memory");
}
__device__ __forceinline__ void convert_weights(const Args& a, int l, unsigned char* ws, LAS unsigned char* lds, int gw, int NGW, int wave, int lane, int gtid, int NGT) {
    LAS float* scr = (LAS float*)(lds + wave * 16384);
    constexpr int I_IN = (DM / 64) * (NCOLS / 32), I_OUT = (DM / 64) * (DM / 32), I_UP = (DM / 64) * (FF2 / 32), I_DN = (FF / 64) * (DM / 32), I_UQ = (256 / 64) * (384 / 32), I_UKV = (128 / 64) * (512 / 32);
    constexpr int NITEMS = I_IN + I_OUT + I_UP + I_DN + I_UQ + I_UKV;
    const float* w_in = a.in[2] + (size_t)l * DM * NCOLS; const float* w_out = a.in[11] + (size_t)l * DM * DM; const float* w_up = a.in[14] + (size_t)l * DM * FF2;
    const float* w_dn = a.in[17] + (size_t)l * FF * DM; const float* w_uq = a.in[5] + (size_t)l * 256 * 384; const float* w_ukv = a.in[7] + (size_t)l * 128 * 512;
    const float* gq = a.in[4] + l * 256; const float* gkv = a.in[6] + l * 128;
    for (int it = gw; it < NITEMS; it += NGW) {
        int r = it;
        if (r < I_IN) { transpose_item(w_in, DM, NCOLS, (bf16*)(ws + WS_WIN), nullptr, scr, r, lane); continue; } r -= I_IN;
        if (r < I_OUT) { transpose_item(w_out, DM, DM, (bf16*)(ws + WS_WOUT), nullptr, scr, r, lane); continue; } r -= I_OUT;
        if (r < I_UP) { transpose_item(w_up, DM, FF2, (bf16*)(ws + WS_WUP), nullptr, scr, r, lane); continue; } r -= I_UP;
        if (r < I_DN) { transpose_item(w_dn, FF, DM, (bf16*)(ws + WS_WDOWN), nullptr, scr, r, lane); continue; } r -= I_DN;
        if (r < I_UQ) { transpose_item(w_uq, 256, 384, (bf16*)(ws + WS_WUQ), gq, scr, r, lane); continue; } r -= I_UQ;
        transpose_item(w_ukv, 128, 512, (bf16*)(ws + WS_WUKV), gkv, scr, r, lane);
    }
    { v4u z = {0u, 0u, 0u, 0u};
      v4u* p1 = (v4u*)(ws + WS_WIN + (size_t)NCOLS * DM * 2); for (int i = gtid; i < (ZP - NCOLS) * DM * 2 / 16; i += NGT) p1[i] = z;
      v4u* p2 = (v4u*)(ws + WS_WUQ + (size_t)384 * 256 * 2); for (int i = gtid; i < 128 * 256 * 2 / 16; i += NGT) p2[i] = z; }
}
__device__ __forceinline__ f32x2 cs_of(float ang) {
    const double rev = (double)ang * 0.15915494309189535; const double fr = rev - __builtin_rint(rev); const float f = (float)fr;
    f32x2 r; r.x = __builtin_amdgcn_cosf(f); r.y = __builtin_amdgcn_sinf(f); return r;
}
__device__ __forceinline__ void build_tables(unsigned char* ws, int gtid, int NGT) {
    f32x2* tf = (f32x2*)(ws + WS_TABF); f32x2* tm = (f32x2*)(ws + WS_TABM);
    for (int i = gtid; i < SEQ * 32; i += NGT) { const int t = i >> 5, k = i & 31; const float inv = (float)exp2(-(double)(2 * k) / 64.0 * 13.287712379549449); tf[i] = cs_of((float)t * inv); }
    for (int i = gtid; i < SEQ * 16; i += NGT) { const int t = i >> 4, k = i & 15; const float inv = (float)exp2(-(double)(2 * k) / 32.0 * 13.287712379549449); tm[i] = cs_of((float)t * inv); }
}
__device__ __forceinline__ void norm_row_to_bf16(const float* xrow, const float* g, bf16* orow, int lane) {
    const f32x4* xr = (const f32x4*)xrow + lane; const f32x4* gr = (const f32x4*)g + lane;
    f32x4 v[4]; float s = 0.f;
#pragma unroll
    for (int j = 0; j < 4; ++j) { v[j] = xr[64 * j]; s += (v[j].x * v[j].x + v[j].y * v[j].y) + (v[j].z * v[j].z + v[j].w * v[j].w); }
    const float r = 1.0f / sqrtf(wave_sum(s) * (1.f / DM) + EPS);
    v2u* o8 = (v2u*)orow + lane;
#pragma unroll
    for (int j = 0; j < 4; ++j) { const f32x4 gg = gr[64 * j]; v2u w; w.x = pk2(v[j].x * r * gg.x, v[j].y * r * gg.y); w.y = pk2(v[j].z * r * gg.z, v[j].w * r * gg.w); o8[64 * j] = w; }
}
__device__ __forceinline__ void resnorm_row(const float* yrow, const float* xin, const float* gpost, float* xout, const float* gnext, bf16* hrow, int lane) {
    const f32x4* yr = (const f32x4*)yrow + lane; const f32x4* xr = (const f32x4*)xin + lane; const f32x4* gp = (const f32x4*)gpost + lane; f32x4* xo = (f32x4*)xout + lane;
    f32x4 v[4]; float s = 0.f;
#pragma unroll
    for (int j = 0; j < 4; ++j) { v[j] = yr[64 * j]; s += (v[j].x * v[j].x + v[j].y * v[j].y) + (v[j].z * v[j].z + v[j].w * v[j].w); }
    const float r = 1.0f / sqrtf(wave_sum(s) * (1.f / DM) + EPS); float s2 = 0.f;
#pragma unroll
    for (int j = 0; j < 4; ++j) { const f32x4 xx = xr[64 * j], gg = gp[64 * j]; v[j] = xx + v[j] * r * gg; xo[64 * j] = v[j]; s2 += (v[j].x * v[j].x + v[j].y * v[j].y) + (v[j].z * v[j].z + v[j].w * v[j].w); }
    if (hrow) { const float r2 = 1.0f / sqrtf(wave_sum(s2) * (1.f / DM) + EPS); const f32x4* gn = (const f32x4*)gnext + lane; v2u* o8 = (v2u*)hrow + lane;
#pragma unroll
        for (int j = 0; j < 4; ++j) { const f32x4 gg = gn[64 * j]; v2u w; w.x = pk2(v[j].x * r2 * gg.x, v[j].y * r2 * gg.y); w.y = pk2(v[j].z * r2 * gg.z, v[j].w * r2 * gg.w); o8[64 * j] = w; } }
}
__device__ __forceinline__ void rope4_store(bf16* p, int i, float n0, float n1, float n2, float n3, f32x2 ta, f32x2 tb, bool axial, bool st) {
    float o0, o1, o2, o3;
    if (axial) { o0 = n0 * ta.x - n1 * ta.y; o1 = n1 * ta.x + n0 * ta.y; o2 = n2 * tb.x - n3 * tb.y; o3 = n3 * tb.x + n2 * tb.y; }
    else { o0 = n0 * ta.x - n2 * ta.y; o2 = n2 * ta.x + n0 * ta.y; o1 = n1 * tb.x - n3 * tb.y; o3 = n3 * tb.x + n1 * tb.y; }
    if (st) { p[i] = (bf16)f2bf(o0); p[16 + i] = (bf16)f2bf(o1); p[32 + i] = (bf16)f2bf(o2); p[48 + i] = (bf16)f2bf(o3); }
}
__device__ __forceinline__ void fixup_row(bf16* zr, int s, const f32x2* tabF, const f32x2* tabM, const float* gq, const float* gk, float* R2, int lane) {
    { const v2u w = *(const v2u*)(zr + ZB_CQ + 4 * lane); const float a0 = bflo(w.x), a1 = bfhi(w.x), a2 = bflo(w.y), a3 = bfhi(w.y);
      const float ss = wave_sum((a0 * a0 + a1 * a1) + (a2 * a2 + a3 * a3));
      const unsigned w2 = *(const unsigned*)(zr + ZB_CKV + 2 * lane); const float b0 = bflo(w2), b1 = bfhi(w2);
      const float ss2 = wave_sum(b0 * b0 + b1 * b1);
      if (lane == 0) { R2[0] = 1.0f / sqrtf(ss * (1.f / 256.f) + EPS); R2[1] = 1.0f / sqrtf(ss2 * (1.f / 128.f) + EPS); } }
    const int hh = lane >> 4, i = lane & 15, row = s >> 6, col = s & 63;
    const f32x2 tr = tabM[row * 16 + i], tc = tabM[col * 16 + i], tf0 = tabF[s * 32 + i], tf1 = tabF[s * 32 + 16 + i], tm = tabM[s * 16 + i];
    { const float x1 = bf2f(zr[ZB_KR + i]), x2 = bf2f(zr[ZB_KR + 16 + i]);
      if (lane < 16) { zr[ZB_KR + i] = (bf16)f2bf(x1 * tm.x - x2 * tm.y); zr[ZB_KR + 16 + i] = (bf16)f2bf(x2 * tm.x + x1 * tm.y); } }
    { bf16* p = zr + ZC_Q + hh * 64; const float e0 = bf2f(p[i]), e1 = bf2f(p[16 + i]), e2 = bf2f(p[32 + i]), e3 = bf2f(p[48 + i]);
      float ss = (e0 * e0 + e1 * e1) + (e2 * e2 + e3 * e3); ss += __shfl_xor(ss, 1); ss += __shfl_xor(ss, 2); ss += __shfl_xor(ss, 4); ss += __shfl_xor(ss, 8);
      const float r = 1.0f / sqrtf(ss * (1.f / 64.f) + EPS);
      rope4_store(p, i, e0 * r * gq[i], e1 * r * gq[16 + i], e2 * r * gq[32 + i], e3 * r * gq[48 + i], tr, tc, true, true); }
    { bf16* p = zr + ZC_K + (hh & 1) * 64; const float e0 = bf2f(p[i]), e1 = bf2f(p[16 + i]), e2 = bf2f(p[32 + i]), e3 = bf2f(p[48 + i]);
      float ss = (e0 * e0 + e1 * e1) + (e2 * e2 + e3 * e3); ss += __shfl_xor(ss, 1); ss += __shfl_xor(ss, 2); ss += __shfl_xor(ss, 4); ss += __shfl_xor(ss, 8);
      const float r = 1.0f / sqrtf(ss * (1.f / 64.f) + EPS);
      rope4_store(p, i, e0 * r * gk[i], e1 * r * gk[16 + i], e2 * r * gk[32 + i], e3 * r * gk[48 + i], tr, tc, true, lane < 32); }
    { bf16* p = zr + ZD_Q + hh * 64; const float e0 = bf2f(p[i]), e1 = bf2f(p[16 + i]), e2 = bf2f(p[32 + i]), e3 = bf2f(p[48 + i]);
      rope4_store(p, i, e0, e1, e2, e3, tf0, tf1, false, true); }
    { bf16* p = zr + ZD_K + (hh & 1) * 64; const float e0 = bf2f(p[i]), e1 = bf2f(p[16 + i]), e2 = bf2f(p[32 + i]), e3 = bf2f(p[48 + i]);
      rope4_store(p, i, e0, e1, e2, e3, tf0, tf1, false, lane < 32); }
}
__device__ __forceinline__ void unpack8(const v4u w, float* f) { f[0] = bflo(w.x); f[1] = bfhi(w.x); f[2] = bflo(w.y); f[3] = bfhi(w.y); f[4] = bflo(w.z); f[5] = bfhi(w.z); f[6] = bflo(w.w); f[7] = bfhi(w.w); }
template <int MODE> __device__ __forceinline__ void naive_attn_unit(const bf16* Z, const bf16* QB, const bf16* KVB, bf16* MIX, const f32x2* tabM, const float* rpb, const float* sink,
                                                                     int b, int head, int qblk, LAS unsigned char* lds, int tid) {
    constexpr int DQ = (MODE == 1) ? 96 : 64;
    LAS float* Ks = (LAS float*)lds; LAS float* Vs = Ks + 64 * DQ; LAS float* Bs = Vs + 64 * 64;
    const int s = qblk * 512 + tid; const size_t t = (size_t)b * SEQ + s; const size_t tb = (size_t)b * SEQ;
    const bf16* qp; const bf16* Ksrc; const bf16* Vsrc; int kp, vp; float scale;
    if (MODE == 0) { qp = Z + t * ZP + ZA_Q + head * 64; Ksrc = Z + tb * ZP + ZA_K + head * 64; Vsrc = Z + tb * ZP + ZA_V + head * 64; kp = ZP; vp = ZP; scale = 0.125f; }
    else if (MODE == 1) { qp = QB + t * QP + head * 96; Ksrc = KVB + tb * QP + head * 128; Vsrc = KVB + tb * QP + head * 128 + 64; kp = QP; vp = QP; scale = 0.10206207261596577f; }
    else if (MODE == 2) { qp = Z + t * ZP + ZC_Q + head * 64; Ksrc = Z + tb * ZP + ZC_K + (head >> 1) * 64; Vsrc = Z + tb * ZP + ZC_V + (head >> 1) * 64; kp = ZP; vp = ZP; scale = 0.125f; }
    else { qp = Z + t * ZP + ZD_Q + head * 64; Ksrc = Z + tb * ZP + ZD_K + (head >> 1) * 64; Vsrc = Z + tb * ZP + ZD_V + (head >> 1) * 64; kp = ZP; vp = ZP; scale = 0.125f; }
    const bf16* K2src = Z + tb * ZP + ZB_KR;
    const float c2 = scale * LOG2E;
    float q[DQ];
#pragma unroll
    for (int d = 0; d < DQ; d += 8) unpack8(*(const v4u*)(qp + d), q + d);
    if (MODE == 1) {
#pragma unroll
        for (int i = 0; i < 16; ++i) { const f32x2 cs = tabM[s * 16 + i]; const float x1 = q[64 + i], x2 = q[80 + i]; q[64 + i] = x1 * cs.x - x2 * cs.y; q[80 + i] = x2 * cs.x + x1 * cs.y; }
    }
    int lo = 0, hi = 128;
    const int r = s >> 6, c = s & 63;
    const int rs = min(max(r - 4, 0), 120), cs0 = min(max(c - 8, 0), 48);
    if (MODE == 0) { const int r0 = qblk * 8; lo = min(max(r0 - 4, 0), 120); hi = min(max(r0 + 7 - 4, 0), 120) + 8; __syncthreads(); if (tid < 465) Bs[tid] = rpb[head * 465 + tid] * LOG2E; }
    if (MODE == 3) { lo = max(qblk * 8 - 2, 0); hi = min(qblk * 8 + 10, 128); }
    float m = -1e30f, l = 0.f; float o[64];
#pragma unroll
    for (int d = 0; d < 64; ++d) o[d] = 0.f;
    if (MODE == 3) { m = sink[head] * LOG2E; l = 1.f; }
    for (int kt = lo; kt < hi; ++kt) {
        __syncthreads();
        { const int j = tid >> 3, ch = tid & 7; float f[8];
          unpack8(*(const v4u*)(Ksrc + (size_t)(kt * 64 + j) * kp + ch * 8), f);
          *(LAS f32x4*)(Ks + j * DQ + ch * 8) = (f32x4){f[0], f[1], f[2], f[3]}; *(LAS f32x4*)(Ks + j * DQ + ch * 8 + 4) = (f32x4){f[4], f[5], f[6], f[7]};
          unpack8(*(const v4u*)(Vsrc + (size_t)(kt * 64 + j) * vp + ch * 8), f);
          *(LAS f32x4*)(Vs + j * 64 + ch * 8) = (f32x4){f[0], f[1], f[2], f[3]}; *(LAS f32x4*)(Vs + j * 64 + ch * 8 + 4) = (f32x4){f[4], f[5], f[6], f[7]};
          if (MODE == 1 && tid < 256) { const int j2 = tid >> 2, c2i = tid & 3; unpack8(*(const v4u*)(K2src + (size_t)(kt * 64 + j2) * ZP + c2i * 8), f);
            *(LAS f32x4*)(Ks + j2 * DQ + 64 + c2i * 8) = (f32x4){f[0], f[1], f[2], f[3]}; *(LAS f32x4*)(Ks + j2 * DQ + 64 + c2i * 8 + 4) = (f32x4){f[4], f[5], f[6], f[7]}; } }
        __syncthreads();
        const bool rowok = (MODE != 0) || (kt >= rs && kt < rs + 8);
        if (rowok) {
            for (int j = 0; j < 64; ++j) {
                bool valid = true;
                if (MODE == 0) valid = (j >= cs0 && j < cs0 + 16);
                if (MODE == 3) { const int d = s - (kt * 64 + j); valid = (d <= 128 && d >= -128); }
                if (valid) {
                    float a0 = 0.f, a1 = 0.f, a2 = 0.f, a3 = 0.f;
#pragma unroll
                    for (int d = 0; d < DQ; d += 4) { const f32x4 k4 = *(const LAS f32x4*)(Ks + j * DQ + d); a0 += q[d] * k4.x; a1 += q[d + 1] * k4.y; a2 += q[d + 2] * k4.z; a3 += q[d + 3] * k4.w; }
                    float s2 = ((a0 + a1) + (a2 + a3)) * c2;
                    if (MODE == 0) s2 += Bs[(kt - r + 7) * 31 + (j - c + 15)];
                    if (s2 > m) { const float al = __builtin_amdgcn_exp2f(m - s2); l *= al;
#pragma unroll
                        for (int d = 0; d < 64; ++d) o[d] *= al;
                        m = s2; }
                    const float p = __builtin_amdgcn_exp2f(s2 - m); l += p;
#pragma unroll
                    for (int d = 0; d < 64; d += 4) { const f32x4 v4 = *(const LAS f32x4*)(Vs + j * 64 + d); o[d] += p * v4.x; o[d + 1] += p * v4.y; o[d + 2] += p * v4.z; o[d + 3] += p * v4.w; }
                }
            }
        }
    }
    const float inv = 1.0f / l;
    bf16* op = MIX + t * DM + MODE * 256 + head * 64;
#pragma unroll
    for (int d = 0; d < 64; d += 8) { v4u w; w.x = pk2(o[d] * inv, o[d + 1] * inv); w.y = pk2(o[d + 2] * inv, o[d + 3] * inv); w.z = pk2(o[d + 4] * inv, o[d + 5] * inv); w.w = pk2(o[d + 6] * inv, o[d + 7] * inv); *(v4u*)(op + d) = w; }
}

typedef short bf16x8_t __attribute__((ext_vector_type(8)));
typedef short s16x4_t __attribute__((ext_vector_type(4)));
typedef float f32x16 __attribute__((ext_vector_type(16)));
__device__ __forceinline__ int crow(int r, int hi) { return (r & 3) + 8 * (r >> 2) + 4 * hi; }
__device__ __forceinline__ s16x4_t vtr(const LAS unsigned char* p) { return __builtin_bit_cast(s16x4_t, __builtin_amdgcn_ds_read_tr16_b64_v4i16((LAS s16x4_t*)p)); }
__device__ __forceinline__ unsigned cvtpk(float lo, float hi) { typedef float f2 __attribute__((ext_vector_type(2))); typedef __bf16 b2 __attribute__((ext_vector_type(2))); f2 v = {lo, hi}; b2 b = __builtin_convertvector(v, b2); return __builtin_bit_cast(unsigned, b); }
template <int MODE> __device__ __forceinline__ void fa_unit(const bf16* Zp, const bf16* QBp, const bf16* KVBp, bf16* MIXp, const f32x2* tabMp, const float* rpb, const float* sink,
                                                             int b, int head, int qblk, LAS unsigned char* lds, int tid) {
    constexpr int DQ = (MODE == 1) ? 96 : 64, NC = DQ / 16, PK = DQ * 2 + 16, PV = 192, KBYTES = 64 * PK, VBYTES = 64 * PV, BUF = KBYTES + VBYTES;
    constexpr float THR = 4.0f;
    const int lane = tid & 63, wave = __builtin_amdgcn_readfirstlane(tid >> 6), r32 = lane & 31, hi = lane >> 5;
    LAS float* wsf = (LAS float*)(lds + 2 * BUF) + wave * 32; LAS float* Bs = (LAS float*)(lds + 2 * BUF + 8 * 32 * 4);
    const int q0 = qblk * 256, w0 = q0 + wave * 32, sq = w0 + r32; const size_t tb = (size_t)b * SEQ, t = tb + sq;
    const bf16* qp; const bf16* Ksrc; const bf16* Vsrc; int kp, vp; float scale;
    if (MODE == 0) { qp = Zp + t * ZP + ZA_Q + head * 64; Ksrc = Zp + tb * ZP + ZA_K + head * 64; Vsrc = Zp + tb * ZP + ZA_V + head * 64; kp = ZP; vp = ZP; scale = 0.125f; }
    else if (MODE == 1) { qp = QBp + t * QP + head * 96; Ksrc = KVBp + tb * QP + head * 128; Vsrc = KVBp + tb * QP + head * 128 + 64; kp = QP; vp = QP; scale = 0.10206207261596577f; }
    else if (MODE == 2) { qp = Zp + t * ZP + ZC_Q + head * 64; Ksrc = Zp + tb * ZP + ZC_K + (head >> 1) * 64; Vsrc = Zp + tb * ZP + ZC_V + (head >> 1) * 64; kp = ZP; vp = ZP; scale = 0.125f; }
    else { qp = Zp + t * ZP + ZD_Q + head * 64; Ksrc = Zp + tb * ZP + ZD_K + (head >> 1) * 64; Vsrc = Zp + tb * ZP + ZD_V + (head >> 1) * 64; kp = ZP; vp = ZP; scale = 0.125f; }
    const bf16* K2src = Zp + tb * ZP + ZB_KR;
    const float c2 = scale * LOG2E;
    bf16x8_t qf[NC];
#pragma unroll
    for (int c = 0; c < NC; ++c) qf[c] = *(const bf16x8_t*)(qp + 16 * c + 8 * hi);
    if (MODE == 1) {
#pragma unroll
        for (int j = 0; j < 8; ++j) { const f32x2 cs = tabMp[sq * 16 + 8 * hi + j]; const float x1 = bf2f((unsigned short)qf[NC - 2][j]), x2 = bf2f((unsigned short)qf[NC - 1][j]);
            qf[NC - 2][j] = (short)f2bf(x1 * cs.x - x2 * cs.y); qf[NC - 1][j] = (short)f2bf(x2 * cs.x + x1 * cs.y); }
    }
    int lo = 0, hit = 128;
    const int rw = w0 >> 6, rs = min(max(rw - 4, 0), 120), cq = sq & 63, cs0 = min(max(cq - 8, 0), 48);
    if (MODE == 0) { const int r0 = qblk * 4; lo = min(max(r0 - 4, 0), 120); hit = min(max(r0 + 3 - 4, 0), 120) + 8; if (tid < 465) Bs[tid] = rpb[head * 465 + tid] * LOG2E; }
    if (MODE == 3) { lo = max(qblk * 4 - 2, 0); hit = min(qblk * 4 + 6, 128); }
    f32x16 o0, o1;
#pragma unroll
    for (int r = 0; r < 16; ++r) { o0[r] = 0.f; o1[r] = 0.f; }
    float mref = -1e30f, l = 0.f;
    if (MODE == 3) { mref = sink[head] * LOG2E; l = (hi == 0) ? 1.f : 0.f; }
    v4u kreg, vreg, k2reg = {0u, 0u, 0u, 0u};
#define FA_GLOAD(kt) do { kreg = *(const v4u*)(Ksrc + (size_t)((kt) * 64 + (tid >> 3)) * kp + (tid & 7) * 8); vreg = *(const v4u*)(Vsrc + (size_t)((kt) * 64 + (tid >> 3)) * vp + (tid & 7) * 8); \
        if (MODE == 1 && tid < 256) k2reg = *(const v4u*)(K2src + (size_t)((kt) * 64 + (tid >> 2)) * ZP + (tid & 3) * 8); } while (0)
#define FA_LSTORE(buf) do { *(LAS v4u*)(lds + (buf) * BUF + (tid >> 3) * PK + (tid & 7) * 16) = kreg; *(LAS v4u*)(lds + (buf) * BUF + KBYTES + (tid >> 3) * PV + (tid & 7) * 16) = vreg; \
        if (MODE == 1 && tid < 256) *(LAS v4u*)(lds + (buf) * BUF + (tid >> 2) * PK + 128 + (tid & 3) * 16) = k2reg; } while (0)
    FA_GLOAD(lo); FA_LSTORE(lo & 1);
    __syncthreads();
    for (int kt = lo; kt < hit; ++kt) {
        const bool more = (kt + 1 < hit);
        if (more) FA_GLOAD(kt + 1);
        bool rel = true;
        if (MODE == 0) rel = (kt >= rs && kt < rs + 8);
        if (MODE == 3) rel = (kt * 64 + 63 >= w0 - 128) && (kt * 64 <= w0 + 31 + 128);
        if (rel) {
            const LAS unsigned char* Kb = lds + (kt & 1) * BUF; const LAS unsigned char* Vb = Kb + KBYTES;
            f32x16 p0, p1;
#pragma unroll
            for (int r = 0; r < 16; ++r) { p0[r] = 0.f; p1[r] = 0.f; }
#pragma unroll
            for (int c = 0; c < NC; ++c) {
                const bf16x8_t kA0 = *(const LAS bf16x8_t*)(Kb + r32 * PK + c * 32 + hi * 16);
                const bf16x8_t kA1 = *(const LAS bf16x8_t*)(Kb + (32 + r32) * PK + c * 32 + hi * 16);
                p0 = __builtin_amdgcn_mfma_f32_32x32x16_bf16(kA0, qf[c], p0, 0, 0, 0);
                p1 = __builtin_amdgcn_mfma_f32_32x32x16_bf16(kA1, qf[c], p1, 0, 0, 0);
            }
            float mx = -3e38f;
            if (MODE == 1 || MODE == 2) {
#pragma unroll
                for (int r = 0; r < 16; ++r) mx = fmaxf(mx, fmaxf(p0[r], p1[r]));
                mx *= c2;
            } else if (MODE == 0) {
#pragma unroll
                for (int r = 0; r < 16; ++r) { const int j0 = crow(r, hi), j1 = j0 + 32; const bool v0 = (j0 >= cs0 && j0 < cs0 + 16), v1 = (j1 >= cs0 && j1 < cs0 + 16);
                    const int i0 = v0 ? (kt - rw + 7) * 31 + (j0 - cq + 15) : 0, i1 = v1 ? (kt - rw + 7) * 31 + (j1 - cq + 15) : 0;
                    const float s0 = v0 ? (p0[r] * c2 + Bs[i0]) : -1e30f, s1 = v1 ? (p1[r] * c2 + Bs[i1]) : -1e30f;
                    p0[r] = s0; p1[r] = s1; mx = fmaxf(mx, fmaxf(s0, s1)); }
            } else {
#pragma unroll
                for (int r = 0; r < 16; ++r) { const int d0 = sq - (kt * 64 + crow(r, hi)), d1 = d0 - 32; const bool v0 = (d0 <= 128 && d0 >= -128), v1 = (d1 <= 128 && d1 >= -128);
                    const float s0 = v0 ? p0[r] * c2 : -1e30f, s1 = v1 ? p1[r] * c2 : -1e30f; p0[r] = s0; p1[r] = s1; mx = fmaxf(mx, fmaxf(s0, s1)); }
            }
            mx = fmaxf(mx, __shfl_xor(mx, 32));
            if (__any(mx > mref + THR)) {
                const float mnew = fmaxf(mref, mx); const float alpha = __builtin_amdgcn_exp2f(mref - mnew); mref = mnew; l *= alpha;
                if (hi == 0) wsf[r32] = alpha;
#pragma unroll
                for (int r = 0; r < 16; ++r) { const float a = wsf[crow(r, hi)]; o0[r] *= a; o1[r] *= a; }
            }
            float ps = 0.f;
            if (MODE == 1 || MODE == 2) {
#pragma unroll
                for (int r = 0; r < 16; ++r) { p0[r] = __builtin_amdgcn_exp2f(p0[r] * c2 - mref); p1[r] = __builtin_amdgcn_exp2f(p1[r] * c2 - mref); ps += p0[r] + p1[r]; }
            } else {
#pragma unroll
                for (int r = 0; r < 16; ++r) { p0[r] = __builtin_amdgcn_exp2f(p0[r] - mref); p1[r] = __builtin_amdgcn_exp2f(p1[r] - mref); ps += p0[r] + p1[r]; }
            }
            l += ps;
            v4u pw[4];
            pw[0] = (v4u){cvtpk(p0[0], p0[1]), cvtpk(p0[2], p0[3]), cvtpk(p0[4], p0[5]), cvtpk(p0[6], p0[7])};
            pw[1] = (v4u){cvtpk(p0[8], p0[9]), cvtpk(p0[10], p0[11]), cvtpk(p0[12], p0[13]), cvtpk(p0[14], p0[15])};
            pw[2] = (v4u){cvtpk(p1[0], p1[1]), cvtpk(p1[2], p1[3]), cvtpk(p1[4], p1[5]), cvtpk(p1[6], p1[7])};
            pw[3] = (v4u){cvtpk(p1[8], p1[9]), cvtpk(p1[10], p1[11]), cvtpk(p1[12], p1[13]), cvtpk(p1[14], p1[15])};
            const LAS unsigned char* vbase = Vb + (4 * hi + ((lane & 15) >> 2)) * PV + (16 * ((lane >> 4) & 1) + 4 * (lane & 3)) * 2;
#pragma unroll
            for (int s4 = 0; s4 < 4; ++s4) {
                const bf16x8_t pa = __builtin_bit_cast(bf16x8_t, pw[s4]);
#pragma unroll
                for (int db = 0; db < 2; ++db) {
                    const LAS unsigned char* ad = vbase + (32 * (s4 >> 1) + 16 * (s4 & 1)) * PV + db * 64;
                    const s16x4_t t0 = vtr(ad), t1 = vtr(ad + 8 * PV);
                    const bf16x8_t vB = {t0[0], t0[1], t0[2], t0[3], t1[0], t1[1], t1[2], t1[3]};
                    if (db == 0) o0 = __builtin_amdgcn_mfma_f32_32x32x16_bf16(pa, vB, o0, 0, 0, 0); else o1 = __builtin_amdgcn_mfma_f32_32x32x16_bf16(pa, vB, o1, 0, 0, 0);
                }
            }
        }
        if (more) FA_LSTORE((kt + 1) & 1);
        __syncthreads();
    }
#undef FA_GLOAD
#undef FA_LSTORE
    l += __shfl_xor(l, 32);
    if (hi == 0) wsf[r32] = 1.0f / l;
    bf16* op = MIXp + (tb + w0) * DM + MODE * 256 + head * 64 + r32;
#pragma unroll
    for (int r = 0; r < 16; ++r) { const int row = crow(r, hi); const float il = wsf[row]; op[(size_t)row * DM] = (bf16)f2bf(o0[r] * il); op[(size_t)row * DM + 32] = (bf16)f2bf(o1[r] * il); }
}
__device__ __forceinline__ float gelu_tanh(float x) {
    const float z = 0.7978845608028654f * (x + 0.044715f * x * x * x);
    const float e = __builtin_amdgcn_exp2f(z * (2.0f * LOG2E));
    const float th = 1.0f - 2.0f * __builtin_amdgcn_rcpf(e + 1.0f);
    return 0.5f * x * (1.0f + th);
}
__device__ __forceinline__ void conv_phase(const bf16* U, bf16* Gout  , const float* cw, const float* cb, int gtid, int NGT) {
    constexpr int CG = FF / 8, RC = 16;
    for (int item = gtid; item < (SEQ / RC) * CG; item += NGT) {
        const int cgi = item % CG, rc = item / CG, n = cgi * 8, s0 = rc * RC;
        float wg[3][8], wv[3][8], bg[8], bv[8];
#pragma unroll
        for (int i = 0; i < 3; ++i) {
#pragma unroll
            for (int e = 0; e < 8; e += 4) { const f32x4 a = *(const f32x4*)(cw + (size_t)i * FF2 + n + e), bq = *(const f32x4*)(cw + (size_t)i * FF2 + FF + n + e);
                wg[i][e] = a.x; wg[i][e + 1] = a.y; wg[i][e + 2] = a.z; wg[i][e + 3] = a.w; wv[i][e] = bq.x; wv[i][e + 1] = bq.y; wv[i][e + 2] = bq.z; wv[i][e + 3] = bq.w; } }
#pragma unroll
        for (int e = 0; e < 8; e += 4) { const f32x4 a = *(const f32x4*)(cb + n + e), bq = *(const f32x4*)(cb + FF + n + e);
            bg[e] = a.x; bg[e + 1] = a.y; bg[e + 2] = a.z; bg[e + 3] = a.w; bv[e] = bq.x; bv[e + 1] = bq.y; bv[e + 2] = bq.z; bv[e + 3] = bq.w; }
        float pg[8], pv[8], cgv[8], cv[8], ng[8], nv[8];
        if (s0 > 0) { unpack8(*(const v4u*)(U + (size_t)(s0 - 1) * FF2 + n), pg); unpack8(*(const v4u*)(U + (size_t)(s0 - 1) * FF2 + FF + n), pv); }
        else {
#pragma unroll
            for (int e = 0; e < 8; ++e) { pg[e] = 0.f; pv[e] = 0.f; } }
        unpack8(*(const v4u*)(U + (size_t)s0 * FF2 + n), cgv); unpack8(*(const v4u*)(U + (size_t)s0 * FF2 + FF + n), cv);
        for (int rr = 0; rr < RC; ++rr) {
            const int s = s0 + rr;
            if (s + 1 < SEQ) { unpack8(*(const v4u*)(U + (size_t)(s + 1) * FF2 + n), ng); unpack8(*(const v4u*)(U + (size_t)(s + 1) * FF2 + FF + n), nv); }
            else {
#pragma unroll
                for (int e = 0; e < 8; ++e) { ng[e] = 0.f; nv[e] = 0.f; } }
            float res[8];
#pragma unroll
            for (int e = 0; e < 8; ++e) { const float gate = bg[e] + pg[e] * wg[0][e] + cgv[e] * wg[1][e] + ng[e] * wg[2][e]; const float val = bv[e] + pv[e] * wv[0][e] + cv[e] * wv[1][e] + nv[e] * wv[2][e];
                res[e] = gelu_tanh(gate) * val; }
            v4u w; w.x = pk2(res[0], res[1]); w.y = pk2(res[2], res[3]); w.z = pk2(res[4], res[5]); w.w = pk2(res[6], res[7]);
            *(v4u*)(Gout + (size_t)s * FF + n) = w;
#pragma unroll
            for (int e = 0; e < 8; ++e) { pg[e] = cgv[e]; pv[e] = cv[e]; cgv[e] = ng[e]; cv[e] = nv[e]; }
        }
    }
}

#define RLX_AGENT __ATOMIC_RELAXED, __HIP_MEMORY_SCOPE_AGENT
#define XB_TMO      128
#define XB_XCNT(j)  (256  + 64 * (j))
#define XB_XSUB(j)  (1280 + 64 * (j))
#define XB_XGEN(j)  (2304 + 64 * (j))
#define XB_TOP      3328
#define XB_TOPGEN   3392
#define XCD_BAR_WORDS 3456
#define XB_SPIN_CAP (1u << 18)

__device__ __forceinline__ unsigned xb_ld(unsigned* p)              { return __hip_atomic_load(p, __ATOMIC_RELAXED, __HIP_MEMORY_SCOPE_AGENT); }
__device__ __forceinline__ unsigned xb_add(unsigned* p, unsigned v) { return __hip_atomic_fetch_add(p, v, __ATOMIC_RELAXED, __HIP_MEMORY_SCOPE_AGENT); }
__device__ __forceinline__ unsigned xb_xcc_id() { return (unsigned)__builtin_amdgcn_s_getreg((3 << 11) | 20) & 0xFu; }
#define XB_SPIN(cond, bar) do { unsigned _sp = 0; while (cond) { __builtin_amdgcn_s_sleep(1); \
    if ((++_sp & 255u) == 0u) { if (xb_ld(&(bar)[XB_TMO])) break; if (_sp > XB_SPIN_CAP) { atomicAdd(&(bar)[XB_TMO], 1u); break; } } } } while (0)

struct XcdBarrier {
    unsigned* bar; unsigned x;
    volatile LAS unsigned* st;
};

__device__ __forceinline__ XcdBarrier xcd_barrier_post(unsigned* bar, volatile LAS unsigned* st) {
    XcdBarrier b; b.bar = bar; b.x = xb_xcc_id(); b.st = st;
    if (threadIdx.x == 0) (void)xb_add(&bar[XB_XCNT(b.x)], 1u);
    return b;
}
__device__ __forceinline__ void xcd_barrier_complete(unsigned* bar, unsigned x, unsigned& nloc, unsigned& nx) {
    const unsigned G = gridDim.x * gridDim.y * gridDim.z;
    unsigned sum, cnt, mine, sp = 0u;
    for (;;) {
        sum = 0u; cnt = 0u; mine = 0u;
#pragma unroll
        for (unsigned j = 0; j < 16; ++j) { const unsigned c = xb_ld(&bar[XB_XCNT(j)]); sum += c; cnt += (c > 0u) ? 1u : 0u; mine = (j == x) ? c : mine; }
        if (sum == G) break;
        __builtin_amdgcn_s_sleep(1);
        if ((++sp & 255u) == 0u) { if (xb_ld(&bar[XB_TMO])) break; if (sp > XB_SPIN_CAP) { atomicAdd(&bar[XB_TMO], 1u); break; } }
    }
    nloc = mine > 0u ? mine : 1u; nx = cnt > 0u ? cnt : 1u;
}

__device__ __forceinline__ void xcd_barrier(const XcdBarrier& b) {
    asm volatile("s_waitcnt vmcnt(0)" ::: "memory");
    __syncthreads();
    if (threadIdx.x == 0) {
        unsigned* bar = b.bar;
        __builtin_amdgcn_s_waitcnt(0);
        unsigned nloc = b.st[0], nx = b.st[1];
        if (nloc == 0u) { xcd_barrier_complete(bar, b.x, nloc, nx); b.st[0] = nloc; b.st[1] = nx; }
        const unsigned old = xb_add(&bar[XB_XSUB(b.x)], 1u);
        const unsigned gen = old / nloc;
        if (old + 1u == (gen + 1u) * nloc) {
            __builtin_amdgcn_fence(__ATOMIC_RELEASE, "agent");
            asm volatile("s_waitcnt vmcnt(0)" ::: "memory");
            const unsigned og = xb_add(&bar[XB_TOP], 1u);
            const unsigned tg = og / nx;
            if (og + 1u == (tg + 1u) * nx) xb_add(&bar[XB_TOPGEN], 1u);
            else XB_SPIN(xb_ld(&bar[XB_TOPGEN]) == tg, bar);
            __builtin_amdgcn_fence(__ATOMIC_ACQUIRE, "agent");
            xb_add(&bar[XB_XGEN(b.x)], 1u);
            asm volatile("s_waitcnt vmcnt(0)" ::: "memory");
        } else {
            XB_SPIN(xb_ld(&bar[XB_XGEN(b.x)]) == gen, bar);
            __builtin_amdgcn_fence(__ATOMIC_ACQUIRE, "agent");
            asm volatile("s_waitcnt vmcnt(0)" ::: "memory");
        }
    }
    __syncthreads();
}

__global__ void __launch_bounds__(512, 2) fwd(Args a) {
    extern __shared__ __attribute__((aligned(16))) unsigned char lds_raw[];
    cg::grid_group grid = cg::this_grid();
    LAS unsigned char* lds = (LAS unsigned char*)lds_raw;
#define PHASE_IDS int tid_ = threadIdx.x; asm volatile("" : "+v"(tid_)); const int tid = tid_, lane = tid & 63, wave = __builtin_amdgcn_readfirstlane(tid >> 6), G = gridDim.x, bx = blockIdx.x; \
    const int gw = bx * 8 + wave, NGW = G * 8, gtid = bx * 512 + tid, NGT = G * 512; (void)lane; (void)gw; (void)NGW; (void)gtid; (void)NGT;
    unsigned char* ws = a.ws;
#define WinT ((bf16*)(ws + WS_WIN))
#define WoutT ((bf16*)(ws + WS_WOUT))
#define WupT ((bf16*)(ws + WS_WUP))
#define WdnT ((bf16*)(ws + WS_WDOWN))
#define WuqT ((bf16*)(ws + WS_WUQ))
#define WukvT ((bf16*)(ws + WS_WUKV))
#define H ((bf16*)(ws + WS_H))
#define Z ((bf16*)(ws + WS_Z))
#define QB ((bf16*)(ws + WS_QB))
#define KVB ((bf16*)(ws + WS_KVB))
#define MIX ((bf16*)(ws + WS_MIX))
#define Y ((float*)(ws + WS_Y))
#define U ((bf16*)(ws + WS_U))
#define Gb ((bf16*)(ws + WS_G))
#define R ((float*)(ws + WS_R))
#define tabF ((const f32x2*)(ws + WS_TABF))
#define tabM ((const f32x2*)(ws + WS_TABM))
#define x0 (a.in[0])
#define out (a.out)


    volatile LAS unsigned* MISC = (volatile LAS unsigned*)(lds + 131072 + 320);
    unsigned* barw = (unsigned*)(ws + WS_BAR);
    { const int t0_ = threadIdx.x; if (t0_ < 32) MISC[t0_] = 0u; if (blockIdx.x == 0) for (int i = t0_; i < XCD_BAR_WORDS; i += 512) barw[i] = 0u; }
    __syncthreads();
    { PHASE_IDS
    convert_weights(a, 0, ws, lds, gw, NGW, wave, lane, gtid, NGT);
#ifndef NO_TAB
    build_tables(ws, gtid, NGT);
#endif
    for (int t = gw; t < NT; t += NGW) norm_row_to_bf16(x0 + (size_t)t * DM, a.in[1], H + (size_t)t * DM, lane);
    }
    grid.sync();
    XcdBarrier bar = xcd_barrier_post(barw, MISC + 8);
#define GRID_BAR() xcd_barrier(bar)

#pragma unroll 1
    for (int l = 0; l < 2; ++l) {
#ifdef PROBE_SYNC
        for (int rep = 0; rep < 20; ++rep) GRID_BAR();
#endif
        { const int G = gridDim.x, bx = blockIdx.x; pg8::Gemm g{H, WinT, NT, ZP, DM, DM, DM}; pg8::StaticOrder S; S.init(NT, ZP, G, bx);
          pg8::EpiBf16<0> E{Z, ZP, nullptr, 0, 0, 1.f};
          pg8::gemm_phase<pg8::EpiBf16<0>, pg8::StaticOrder, true, true>(lds, g, S, E); }
        GRID_BAR();
#ifndef NO_FIX
        { PHASE_IDS
        for (int t = gw; t < NT; t += NGW) fixup_row(Z + (size_t)t * ZP, t & (SEQ - 1), tabF, tabM, a.in[8] + l * 64, a.in[9] + l * 64, R + (size_t)t * 2, lane); }
#endif
        GRID_BAR();
        { const int G = gridDim.x, bx = blockIdx.x; pg8::Gemm g{Z + ZB_CQ, WuqT, NT, 512, 256, ZP, 256}; pg8::StaticOrder S; S.init(NT, 512, G, bx);
          pg8::EpiBf16Row E{QB, QP, R, 0};
          pg8::gemm_phase<pg8::EpiBf16Row, pg8::StaticOrder, true, true>(lds, g, S, E); }
        { const int G = gridDim.x, bx = blockIdx.x; pg8::Gemm g{Z + ZB_CKV, WukvT, NT, 512, 128, ZP, 128}; pg8::StaticOrder S; S.init(NT, 512, G, (bx + G / 2) % G);
          pg8::EpiBf16Row E{KVB, QP, R, 1};
          pg8::gemm_phase<pg8::EpiBf16Row, pg8::StaticOrder, true, true>(lds, g, S, E); }
        GRID_BAR();
#ifndef NO_ATTN
        { PHASE_IDS
        const float* rpb = a.in[3] + (size_t)l * 4 * 465; const float* sink = a.in[10] + l * 4;
#ifdef PROBE_ATTN2
        for (int rep = 0; rep < 2; ++rep)
#endif
        for (int u = bx; u < 1024; u += G) {
            const int kind = u >> 8, v = u & 255, bh = v & 7, b = bh >> 2, head = bh & 3, qblk = v >> 3;
            if (kind == 0) fa_unit<1>(Z, QB, KVB, MIX, tabM, rpb, sink, b, head, qblk, lds, tid);
            else if (kind == 1) fa_unit<2>(Z, QB, KVB, MIX, tabM, rpb, sink, b, head, qblk, lds, tid);
            else if (kind == 2) fa_unit<0>(Z, QB, KVB, MIX, tabM, rpb, sink, b, head, qblk, lds, tid);
            else fa_unit<3>(Z, QB, KVB, MIX, tabM, rpb, sink, b, head, qblk, lds, tid);
            __syncthreads();
        } }
#endif
        GRID_BAR();
        { const int G = gridDim.x, bx = blockIdx.x; pg8::Gemm g{MIX, WoutT, NT, DM, DM, DM, DM}; pg8::StaticOrder S; S.init(NT, DM, G, bx);
          pg8::EpiF32 E{Y, DM};
          pg8::gemm_phase<pg8::EpiF32, pg8::StaticOrder, true, true>(lds, g, S, E); }
        GRID_BAR();
        { PHASE_IDS const float* xin = (l == 0) ? x0 : out;
          for (int t = gw; t < NT; t += NGW) resnorm_row(Y + (size_t)t * DM, xin + (size_t)t * DM, a.in[12] + l * DM, out + (size_t)t * DM, a.in[13] + l * DM, H + (size_t)t * DM, lane); }
        GRID_BAR();
#pragma unroll 1
        for (int hb = 0; hb < 2; ++hb) {
            { const int G = gridDim.x, bx = blockIdx.x; pg8::Gemm g{H + (size_t)hb * SEQ * DM, WupT, SEQ, FF2, DM, DM, DM}; pg8::StaticOrder S; S.init(SEQ, FF2, G, bx);
              pg8::EpiBf16<0> E{U, FF2, nullptr, 0, 0, 1.f};
              pg8::gemm_phase<pg8::EpiBf16<0>, pg8::StaticOrder, true, true>(lds, g, S, E); }
            GRID_BAR();
#ifndef NO_CONV
            { PHASE_IDS conv_phase(U, Gb + (size_t)hb * SEQ * FF, a.in[15] + (size_t)l * 3 * FF2, a.in[16] + (size_t)l * FF2, gtid, NGT); }
#endif
            GRID_BAR();
        }
        { const int G = gridDim.x, bx = blockIdx.x; pg8::Gemm g{Gb, WdnT, NT, DM, FF, FF, FF}; pg8::StaticOrder S; S.init(NT, DM, G, bx);
          pg8::EpiF32 E{Y, DM};
          pg8::gemm_phase<pg8::EpiF32, pg8::StaticOrder, true, true>(lds, g, S, E); }
        GRID_BAR();
        { PHASE_IDS
        for (int t = gw; t < NT; t += NGW) resnorm_row(Y + (size_t)t * DM, out + (size_t)t * DM, a.in[18] + l * DM, out + (size_t)t * DM, a.in[1] + DM, (l == 0) ? H + (size_t)t * DM : nullptr, lane);
        if (l == 0) { convert_weights(a, 1, ws, lds, gw, NGW, wave, lane, gtid, NGT); } }
        if (l == 0) GRID_BAR();
    }
}

#undef WinT
#undef WoutT
#undef WupT
#undef WdnT
#undef WuqT
#undef WukvT
#undef H
#undef Z
#undef QB
#undef KVB
#undef MIX
#undef Y
#undef U
#undef Gb
#undef R
#undef tabF
#undef tabM
#undef x0
#undef out
extern "C" void kernel_launch(void* const* d_in, const int* in_sizes, int n_in, void* d_out, int out_size, void* d_ws, size_t ws_size, hipStream_t stream) {
    static int grid = 0;
    if (grid == 0) {
        int dev = 0, cus = 0, per_cu = 0;
        hipGetDevice(&dev); hipDeviceGetAttribute(&cus, hipDeviceAttributeMultiprocessorCount, dev);
        hipFuncSetAttribute((const void*)fwd, hipFuncAttributeMaxDynamicSharedMemorySize, LDS_BYTES);
        hipOccupancyMaxActiveBlocksPerMultiprocessor(&per_cu, (const void*)fwd, 512, LDS_BYTES);
        if (per_cu < 1) { fprintf(stderr, "occupancy query says %d blocks/CU\n", per_cu); per_cu = 1; }
        grid = cus;
        if (ws_size < WS_END) { fprintf(stderr, "workspace too small: %zu < %zu\n", ws_size, (size_t)WS_END); grid = -1; }
    }
    if (grid < 0) return;
    Args a{};
    for (int i = 0; i < 19; ++i) a.in[i] = (const float*)d_in[i];
    a.out = (float*)d_out; a.ws = (unsigned char*)d_ws;
    void* args[] = {&a};
    hipError_t e = hipLaunchCooperativeKernel((const void*)fwd, dim3(grid), dim3(512), args, LDS_BYTES, stream);
    if (e != hipSuccess) fprintf(stderr, "cooperative launch failed: %s (grid %d)\n", hipGetErrorString(e), grid);
}
```

```cpp
#include <hip/hip_runtime.h>
#include <hip/hip_cooperative_groups.h>
#include <cstdio>
#include <cstdint>
namespace pg8 {
#define PG8_LAS __attribute__((address_space(3)))
typedef unsigned short bf16_t;
typedef short bf16x8 __attribute__((ext_vector_type(8)));
typedef float f32x4 __attribute__((ext_vector_type(4)));
typedef unsigned u32x4 __attribute__((ext_vector_type(4)));
constexpr int BM = 256, BK = 64, HALF = 128, HTB = HALF * BK * 2  , STAGE_BYTES = 8 * HTB, NXCD = 8, WGM = 8;

__host__ __device__ __forceinline__ int lds_byte(int r, int c) { const int st = (r >> 4) * 2 + (c >> 5), rr = r & 15, cc = c & 31, ob = rr * 64 + cc * 2; return st * 1024 + (ob ^ (((ob >> 9) & 1) << 5)); }
__host__ __device__ __forceinline__ void stage_rc(int b, int& R, int& C) { const int st = b / 1024, sb = b % 1024, swz = sb ^ (((sb >> 9) & 1) << 5); R = (st >> 1) * 16 + swz / 64; C = (st & 1) * 32 + (swz % 64) / 2; }
__host__ __device__ __forceinline__ int perm32(int rho) { const int n = rho >> 4, i = rho & 15; return 8 * (i >> 2) + 4 * n + (i & 3); }

struct Unit { int pm, pn; };
struct Gemm { const bf16_t* A; const bf16_t* Bt; int M, N, K, lda, ldb; };

struct StaticOrder {
    int nM, nN, nwg, G, c;
    __host__ __device__ void init(int M, int N, int G_, int c_) { nM = M / BM; nN = N / BM; nwg = nM * nN; G = G_; c = c_; }
    __host__ __device__ bool next(int i, Unit& u) const {
        const long L = (long)i * G + c; if (L >= nwg) return false;
        int wgid = (int)L; { const int q = nwg / NXCD, r = nwg % NXCD, xcd = wgid % NXCD, off = wgid / NXCD; wgid = (xcd < r ? xcd * (q + 1) : r * (q + 1) + (xcd - r) * q) + off; }
        const int nig = WGM * nN, gid = wgid / nig, fm = gid * WGM, gsz = (nM - fm) < WGM ? (nM - fm) : WGM;
        u.pm = fm + ((wgid % nig) % gsz); u.pn = (wgid % nig) / gsz; return true;
    }
    __device__ __forceinline__ void a_ready(const Unit&) const {}
    __device__ __forceinline__ void done(const Unit&) const {}
};

__device__ __forceinline__ unsigned cvt_pk_bf16(float lo, float hi) { unsigned r; asm volatile("v_cvt_pk_bf16_f32 %0, %1, %2" : "=v"(r) : "v"(lo), "v"(hi)); return r; }
typedef float f32x2 __attribute__((ext_vector_type(2)));
__device__ __forceinline__ f32x2 gelu_pk(f32x2 v) {
    const f32x2 av = __builtin_elementwise_abs(v), d = av * 0.2316418882f + 1.0f;
    f32x2 t; t.x = __builtin_amdgcn_rcpf(d.x); t.y = __builtin_amdgcn_rcpf(d.y);
    f32x2 q = t * 0.5307027145f + (-0.7265760135f); q = q * t + 0.7107068705f; q = q * t + (-0.142248368f); q = q * t + 0.127414796f; q = q * t;
    const f32x2 s = (v * v) * (-0.72134752044f);
    f32x2 e; e.x = __builtin_amdgcn_exp2f(s.x); e.y = __builtin_amdgcn_exp2f(s.y);
    const f32x2 m = v * (q * e), r = v - m;
    f32x2 o; o.x = v.x < 0.f ? m.x : r.x; o.y = v.y < 0.f ? m.y : r.y; return o;
}

template <int ACT  > struct EpiBf16 {
    static constexpr bool PERM = true, AFTER_DRAIN = false; static_assert(ACT == 0 || ACT == 1, "EpiBf16: ACT is 0 (none) or 1 (gelu_pk)");
    bf16_t* O; int ldc; const float* bias; int split_cols; size_t split_stride; float scale0;
    __device__ __forceinline__ void operator()(const f32x4 (&acc)[2][2][4][2], const Unit& u, int wr, int wc, int fr, int fq) const {
        const int row0 = u.pm * BM + wr * 64 + fr; int colt = u.pn * BM; bf16_t* base = O;
        float sc = 1.f; if (split_cols) { const int t = colt / split_cols; base += (size_t)t * split_stride; colt -= t * split_cols; if (t == 0) sc = scale0; }
        const int col0 = colt + wc * 32 + 8 * fq, bcol0 = u.pn * BM + wc * 32 + 8 * fq;
        f32x4 bv[2][2];
#pragma unroll
        for (int bj = 0; bj < 2; ++bj)
#pragma unroll
            for (int n = 0; n < 2; ++n) bv[bj][n] = bias ? *(const f32x4*)(bias + bcol0 + bj * HALF + 4 * n) : (f32x4){0.f, 0.f, 0.f, 0.f};
#pragma unroll
        for (int ai = 0; ai < 2; ++ai)
#pragma unroll
            for (int m = 0; m < 4; ++m) { bf16_t* rowp = base + (size_t)(row0 + ai * HALF + m * 16) * ldc + col0;
#pragma unroll
                for (int bj = 0; bj < 2; ++bj) { f32x4 v0 = acc[ai][bj][m][0] + bv[bj][0], v1 = acc[ai][bj][m][1] + bv[bj][1];
                    if (ACT == 1) { f32x2 a = gelu_pk((f32x2){v0[0], v0[1]}), b = gelu_pk((f32x2){v0[2], v0[3]}), c = gelu_pk((f32x2){v1[0], v1[1]}), d = gelu_pk((f32x2){v1[2], v1[3]});
                        v0 = (f32x4){a.x, a.y, b.x, b.y}; v1 = (f32x4){c.x, c.y, d.x, d.y}; }
                    v0 = v0 * sc; v1 = v1 * sc; u32x4 w; w.x = cvt_pk_bf16(v0[0], v0[1]); w.y = cvt_pk_bf16(v0[2], v0[3]); w.z = cvt_pk_bf16(v1[0], v1[1]); w.w = cvt_pk_bf16(v1[2], v1[3]);
                    *(u32x4*)(rowp + bj * HALF) = w; } }
    }
};

struct PanelStats {
    unsigned* xbuf;
    unsigned* cnt;
    unsigned* tmo;
    int ntn; float eps;
    unsigned code;
    __device__ __forceinline__ bool run(const f32x4 (&v)[2][2][4][2], const Unit& u, int wr, int wc, int fr, int fq, PG8_LAS unsigned char* lds, int wid, int lane) const {
        typedef float f32x2v __attribute__((ext_vector_type(2)));
        PG8_LAS f32x2v* P = (PG8_LAS f32x2v*)lds;
        PG8_LAS f32x2v* S = (PG8_LAS f32x2v*)(lds + 8192);
        PG8_LAS unsigned* flag = (PG8_LAS unsigned*)(lds + 8192 + 2048);
#pragma unroll
        for (int ai = 0; ai < 2; ++ai)
#pragma unroll
            for (int m = 0; m < 4; ++m) {
                float s = 0.f;
#pragma unroll
                for (int bj = 0; bj < 2; ++bj)
#pragma unroll
                    for (int n = 0; n < 2; ++n) { const f32x4 x = v[ai][bj][m][n]; s += (x[0] + x[1]) + (x[2] + x[3]); }
                s += __shfl_xor(s, 16); s += __shfl_xor(s, 32);
                const float mw = s * (1.0f / 64.0f); float q = 0.f;
#pragma unroll
                for (int bj = 0; bj < 2; ++bj)
#pragma unroll
                    for (int n = 0; n < 2; ++n) { const f32x4 d = v[ai][bj][m][n] - mw; q += (d[0] * d[0] + d[1] * d[1]) + (d[2] * d[2] + d[3] * d[3]); }
                q += __shfl_xor(q, 16); q += __shfl_xor(q, 32);
                if (fq == 0) P[(ai * HALF + wr * 64 + m * 16 + fr) * 4 + wc] = (f32x2v){mw, q};
            }
        asm volatile("s_waitcnt lgkmcnt(0)" ::: "memory"); __builtin_amdgcn_s_barrier(); asm volatile("" ::: "memory");
#if defined(BROKEN_EXCHANGE_NO_WAIT)
#warning BROKEN CONTROL BUILD: the row-statistics exchange does not wait; results are wrong by design
        if (blockIdx.x >= 64) { const long long t0_ = clock64(); while (clock64() - t0_ < 60000) __builtin_amdgcn_s_sleep(8); }
#endif
        const int row = wid * 32 + (lane & 31);
        if (lane < 32) {
            const f32x2v a = P[row * 4 + 0], b = P[row * 4 + 1], c = P[row * 4 + 2], d = P[row * 4 + 3];
            const float mt = (a.x + b.x + c.x + d.x) * 0.25f;
            const float da = a.x - mt, db = b.x - mt, dc = c.x - mt, dd = d.x - mt;
            const float m2 = (a.y + b.y) + (c.y + d.y) + 64.0f * ((da * da + db * db) + (dc * dc + dd * dd));
            unsigned long long* slot = (unsigned long long*)xbuf + ((size_t)(u.pm * BM + row) * 4 + u.pn);
            __hip_atomic_store(slot, ((unsigned long long)__float_as_uint(m2) << 32) | __float_as_uint(mt), __ATOMIC_RELAXED, __HIP_MEMORY_SCOPE_AGENT);
        }
        asm volatile("s_waitcnt vmcnt(0)" ::: "memory");
        if (lane == 0) __hip_atomic_fetch_add(cnt + 64 * u.pm, 1u, __ATOMIC_RELAXED, __HIP_MEMORY_SCOPE_AGENT);
        if (wid == 0) {
            bool dead = false; const unsigned long long t0 = __builtin_amdgcn_s_memrealtime(); const unsigned want = 8u * (unsigned)ntn;
            for (;;) {
#if defined(BROKEN_EXCHANGE_NO_WAIT)
                break;
#endif
                if ((unsigned)__builtin_amdgcn_readfirstlane(__hip_atomic_load(cnt + 64 * u.pm, __ATOMIC_RELAXED, __HIP_MEMORY_SCOPE_AGENT)) >= want) break;
                if (__builtin_amdgcn_s_memrealtime() - t0 > 2000000ull) {
                    if (lane == 0) { unsigned expect = 0u; __hip_atomic_compare_exchange_strong(tmo + 1, &expect, code | (unsigned)(u.pm & 0xff), __ATOMIC_RELAXED, __ATOMIC_RELAXED, __HIP_MEMORY_SCOPE_AGENT);
                                     __hip_atomic_store(tmo, 1u, __ATOMIC_RELAXED, __HIP_MEMORY_SCOPE_AGENT); }
                    dead = true; break; }
                __builtin_amdgcn_s_sleep(2);
            }
            __builtin_amdgcn_fence(__ATOMIC_ACQUIRE, "agent");
            if (lane == 0) flag[0] = dead ? 1u : 0u;
        }
        asm volatile("s_waitcnt vmcnt(0) lgkmcnt(0)" ::: "memory"); __builtin_amdgcn_s_barrier(); asm volatile("" ::: "memory");
        const bool bad = flag[0] != 0u;
        if (lane < 32) {
            const unsigned long long* slot = (const unsigned long long*)xbuf + (size_t)(u.pm * BM + row) * 4; float mt[4], m2[4]; float ms = 0.f;
#pragma unroll
            for (int t = 0; t < 4; ++t) { if (t < ntn) { const unsigned long long w = __hip_atomic_load(slot + t, __ATOMIC_RELAXED, __HIP_MEMORY_SCOPE_AGENT); mt[t] = __uint_as_float((unsigned)w); m2[t] = __uint_as_float((unsigned)(w >> 32)); } else { mt[t] = 0.f; m2[t] = 0.f; } ms += mt[t]; }
            const float mean = ms / (float)ntn; float q = 0.f;
#pragma unroll
            for (int t = 0; t < 4; ++t) if (t < ntn) { const float dm = mt[t] - mean; q += m2[t] + 256.0f * dm * dm; }
            S[row] = (f32x2v){mean, 1.0f / sqrtf(q / (256.0f * (float)ntn) + eps)};
        }
        asm volatile("s_waitcnt lgkmcnt(0)" ::: "memory"); __builtin_amdgcn_s_barrier(); asm volatile("" ::: "memory");
        return bad;
    }
};
struct EpiLnRes {
    static constexpr bool PERM = false, AFTER_DRAIN = true;
    const float* base; float* out; int ldc; const float* bias; PanelStats st; unsigned poison;
    __device__ __forceinline__ void fused(f32x4 (&acc)[2][2][4][2], const Unit& u, int wr, int wc, int fr, int fq, PG8_LAS unsigned char* lds, int wid, int lane) const {
        typedef float f32x2v __attribute__((ext_vector_type(2)));
        const PG8_LAS f32x2v* S = (const PG8_LAS f32x2v*)(lds + 8192);
        const int col0 = u.pn * BM + wc * 32 + 4 * fq;
#pragma unroll
        for (int bj = 0; bj < 2; ++bj)
#pragma unroll
            for (int n = 0; n < 2; ++n) { const f32x4 bv = bias ? *(const f32x4*)(bias + col0 + bj * HALF + n * 16) : (f32x4){0.f, 0.f, 0.f, 0.f};
#pragma unroll
                for (int ai = 0; ai < 2; ++ai)
#pragma unroll
                    for (int m = 0; m < 4; ++m) acc[ai][bj][m][n] += bv; }
        f32x4 pre[4][2][2];
#pragma unroll
        for (int m = 0; m < 4; ++m) { const size_t off = (size_t)(u.pm * BM + wr * 64 + m * 16 + fr) * ldc + col0;
#pragma unroll
            for (int bj = 0; bj < 2; ++bj)
#pragma unroll
                for (int n = 0; n < 2; ++n) pre[m][bj][n] = *(const f32x4*)(base + off + bj * HALF + n * 16); }
        const bool bad = st.run(acc, u, wr, wc, fr, fq, lds, wid, lane) || poison != 0u;
        const float qnan = __builtin_nanf("");
#pragma unroll
        for (int ai = 0; ai < 2; ++ai)
#pragma unroll
            for (int m = 0; m < 4; ++m) { const int r = ai * HALF + wr * 64 + m * 16 + fr; const f32x2v sr = S[r]; const size_t off = (size_t)(u.pm * BM + r) * ldc + col0;
#pragma unroll
                for (int bj = 0; bj < 2; ++bj)
#pragma unroll
                    for (int n = 0; n < 2; ++n) { const f32x4 bs = ai == 0 ? pre[m][bj][n] : *(const f32x4*)(base + off + bj * HALF + n * 16); f32x4 o = bs + (acc[ai][bj][m][n] - sr.x) * sr.y;
                        if (bad) o = (f32x4){qnan, qnan, qnan, qnan}; *(f32x4*)(out + off + bj * HALF + n * 16) = o; }
                if (m & 1) asm volatile("" ::: "memory"); }
    }
};
struct EpiLnResLn {
    static constexpr bool PERM = false, AFTER_DRAIN = true;
    const float* base; float* out; bf16_t* xn; int ldc; const float* bias; PanelStats st1, st2; unsigned poison;
    __device__ __forceinline__ void fused(f32x4 (&acc)[2][2][4][2], const Unit& u, int wr, int wc, int fr, int fq, PG8_LAS unsigned char* lds, int wid, int lane) const {
        typedef float f32x2v __attribute__((ext_vector_type(2))); typedef unsigned u32x2v __attribute__((ext_vector_type(2)));
        const PG8_LAS f32x2v* S = (const PG8_LAS f32x2v*)(lds + 8192);
        const int col0 = u.pn * BM + wc * 32 + 4 * fq;
#pragma unroll
        for (int bj = 0; bj < 2; ++bj)
#pragma unroll
            for (int n = 0; n < 2; ++n) { const f32x4 bv = bias ? *(const f32x4*)(bias + col0 + bj * HALF + n * 16) : (f32x4){0.f, 0.f, 0.f, 0.f};
#pragma unroll
                for (int ai = 0; ai < 2; ++ai)
#pragma unroll
                    for (int m = 0; m < 4; ++m) acc[ai][bj][m][n] += bv; }
        bool bad = st1.run(acc, u, wr, wc, fr, fq, lds, wid, lane) || poison != 0u;
        const float qnan = __builtin_nanf("");
#pragma unroll
        for (int ai = 0; ai < 2; ++ai)
#pragma unroll
            for (int m = 0; m < 4; ++m) { const int r = ai * HALF + wr * 64 + m * 16 + fr; const f32x2v sr = S[r]; const size_t off = (size_t)(u.pm * BM + r) * ldc + col0;
#pragma unroll
                for (int bj = 0; bj < 2; ++bj)
#pragma unroll
                    for (int n = 0; n < 2; ++n) { const f32x4 bs = *(const f32x4*)(base + off + bj * HALF + n * 16); acc[ai][bj][m][n] = bs + (acc[ai][bj][m][n] - sr.x) * sr.y; }
                asm volatile("" : "+v"(acc[ai][0][m][0]), "+v"(acc[ai][0][m][1]), "+v"(acc[ai][1][m][0]), "+v"(acc[ai][1][m][1]));
                if (m & 1) asm volatile("" ::: "memory"); }
        const bool bad1 = bad;
        bad = st2.run(acc, u, wr, wc, fr, fq, lds, wid, lane) || bad;
#pragma unroll
        for (int ai = 0; ai < 2; ++ai)
#pragma unroll
            for (int m = 0; m < 4; ++m) { const int r = ai * HALF + wr * 64 + m * 16 + fr; const f32x2v sr = S[r]; const size_t off = (size_t)(u.pm * BM + r) * ldc + col0;
#pragma unroll
                for (int bj = 0; bj < 2; ++bj)
#pragma unroll
                    for (int n = 0; n < 2; ++n) { const f32x4 x1 = acc[ai][bj][m][n]; *(f32x4*)(out + off + bj * HALF + n * 16) = bad1 ? (f32x4){qnan, qnan, qnan, qnan} : x1;
                        const f32x4 o = (x1 - sr.x) * sr.y; u32x2v w; w.x = cvt_pk_bf16(o[0], o[1]); w.y = cvt_pk_bf16(o[2], o[3]);
                        if (bad) { w.x = 0x7fc07fc0u; w.y = 0x7fc07fc0u; } *(u32x2v*)(xn + off + bj * HALF + n * 16) = w; }
                asm volatile("" ::: "memory"); }
    }
};

template <class Epi, class Sched, bool ALIGN_EPI = false, bool SP2 = false>
__device__ __forceinline__ void gemm_phase(PG8_LAS unsigned char* lds, const Gemm g, const Sched& S, const Epi& E) {
    int tid_ = threadIdx.x; asm volatile("" : "+v"(tid_));
    const int tid = tid_, wid = __builtin_amdgcn_readfirstlane(tid >> 6), lane = tid & 63, wr = wid >> 2, wc = wid & 3, fr = lane & 15, fq = lane >> 4;
    int K_ = g.K, lda_ = g.lda, ldb_ = g.ldb; asm volatile("" : "+s"(K_), "+s"(lda_), "+s"(ldb_));
    const int K = K_, nt = K / BK;
    unsigned voffA[2], voffB[2];
#pragma unroll
    for (int i = 0; i < 2; ++i) { int R, C; stage_rc(tid * 16 + i * 8192, R, C); const int Rb = Epi::PERM ? ((R & ~31) + perm32(R & 31)) : R;
        voffA[i] = (unsigned)(R * lda_ + C) * 2u; voffB[i] = (unsigned)(Rb * ldb_ + C) * 2u; }
    const size_t kstep = (size_t)(BK * 2);
    const size_t hstepA = (size_t)HALF * lda_ * 2, hstepB = (size_t)HALF * ldb_ * 2;
    const size_t tstepA = 2 * hstepA, tstepB = 2 * hstepB;
    const unsigned ldsw = (unsigned)wid * 1024u;
    const int aoff = lds_byte(wr * 64 + fr, fq * 8), boff = lds_byte(wc * 32 + fr, fq * 8);
#define PG8_SA(b, h) (((b) * 2 + (h)) * HTB)
#define PG8_SB(b, h) ((4 + (b) * 2 + (h)) * HTB)
#define PG8_STAGE(bufoff, gbase, voff) do { _Pragma("unroll") for (int _i = 0; _i < 2; ++_i) \
        __builtin_amdgcn_global_load_lds((const unsigned*)((const char*)(gbase) + (voff)[_i]), (PG8_LAS unsigned*)(lds + (bufoff) + ldsw + _i * 8192), 16, 0, 0); } while (0)
#define PG8_LDA(dst, b, h) do { _Pragma("unroll") for (int m = 0; m < 4; ++m) _Pragma("unroll") for (int k = 0; k < 2; ++k) dst[m][k] = *(const PG8_LAS bf16x8*)(lds + PG8_SA(b, h) + aoff + m * 2048 + k * 1024); } while (0)
#define PG8_LDB(dst, b, h) do { _Pragma("unroll") for (int n = 0; n < 2; ++n) _Pragma("unroll") for (int k = 0; k < 2; ++k) dst[n][k] = *(const PG8_LAS bf16x8*)(lds + PG8_SB(b, h) + boff + n * 2048 + k * 1024); } while (0)
#define PG8_MMA(ai, bj, At, Bt) do { __builtin_amdgcn_s_setprio(1); _Pragma("unroll") for (int m = 0; m < 4; ++m) _Pragma("unroll") for (int n = 0; n < 2; ++n) _Pragma("unroll") for (int k = 0; k < 2; ++k) \
        acc[ai][bj][m][n] = __builtin_amdgcn_mfma_f32_16x16x32_bf16(Bt[n][k], At[m][k], acc[ai][bj][m][n], 0, 0, 0); __builtin_amdgcn_s_setprio(0); } while (0)
#define PG8_WAIT_V(n) asm volatile("s_waitcnt vmcnt(" #n ")" ::: "memory")
#define PG8_WAIT_L(n) asm volatile("s_waitcnt lgkmcnt(" #n ")" ::: "memory")
#define PG8_BAR __builtin_amdgcn_s_barrier()
#define PG8_SCHED __builtin_amdgcn_sched_barrier(0)
    Unit cur, nxt; int ui = 0;
    if (!S.next(0, cur)) return;
    f32x4 acc[2][2][4][2];
#pragma unroll
    for (int a = 0; a < 2; ++a)
#pragma unroll
        for (int b = 0; b < 2; ++b)
#pragma unroll
            for (int m = 0; m < 4; ++m)
#pragma unroll
                for (int n = 0; n < 2; ++n) acc[a][b][m][n] = (f32x4){0.f, 0.f, 0.f, 0.f};
    bf16x8 At[4][2], B0[2][2], B1[2][2];
    const char* cA = (const char*)g.A + (size_t)cur.pm * tstepA; const char* cB = (const char*)g.Bt + (size_t)cur.pn * tstepB;
    S.a_ready(cur);
    if constexpr (SP2) {
        PG8_STAGE(PG8_SB(0, 0), cB, voffB); PG8_STAGE(PG8_SB(0, 1), cB + hstepB, voffB); PG8_STAGE(PG8_SA(0, 0), cA, voffA); PG8_STAGE(PG8_SA(0, 1), cA + hstepA, voffA);
        if (wr == 1) PG8_BAR;
        PG8_WAIT_V(2); PG8_BAR;
        PG8_STAGE(PG8_SB(1, 0), cB + kstep, voffB); PG8_STAGE(PG8_SA(1, 0), cA + kstep, voffA); PG8_STAGE(PG8_SB(1, 1), cB + hstepB + kstep, voffB);
        PG8_WAIT_V(6); PG8_BAR;
    } else {
        PG8_STAGE(PG8_SB(0, 0), cB, voffB); PG8_STAGE(PG8_SA(0, 0), cA, voffA); PG8_STAGE(PG8_SB(0, 1), cB + hstepB, voffB); PG8_STAGE(PG8_SA(0, 1), cA + hstepA, voffA);
        if (wr == 1) PG8_BAR;
        PG8_WAIT_V(4); PG8_BAR;
        PG8_STAGE(PG8_SB(1, 0), cB + kstep, voffB); PG8_STAGE(PG8_SA(1, 0), cA + kstep, voffA); PG8_STAGE(PG8_SB(1, 1), cB + hstepB + kstep, voffB);
        PG8_WAIT_V(6); PG8_BAR;
    }
    for (;;) {
        const bool has_next = S.next(ui + 1, nxt);
        const char* nA = has_next ? (const char*)g.A + (size_t)nxt.pm * tstepA : cA; const char* nB = has_next ? (const char*)g.Bt + (size_t)nxt.pn * tstepB : cB;
        for (int t = 0; t < nt; t += 2) {
            const bool last = (t == nt - 2);
            const char* a1 = cA + (size_t)(t + 1) * kstep;
            const char* a2 = last ? nA : cA + (size_t)(t + 2) * kstep; const char* b2 = last ? nB : cB + (size_t)(t + 2) * kstep;
            const char* a3 = a2 + kstep; const char* b3 = b2 + kstep;
            if (last && has_next) S.a_ready(nxt);
            if constexpr (SP2) {
            PG8_LDB(B0, 0, 0); PG8_LDB(B1, 0, 1); PG8_SCHED; PG8_LDA(At, 0, 0); PG8_STAGE(PG8_SA(1, 1), a1 + hstepA, voffA);
            PG8_WAIT_V(8); PG8_WAIT_L(0); PG8_BAR; PG8_MMA(0, 0, At, B0); PG8_MMA(0, 1, At, B1); PG8_BAR; PG8_SCHED;
            PG8_LDA(At, 0, 1); PG8_STAGE(PG8_SB(0, 0), b2, voffB); PG8_STAGE(PG8_SB(0, 1), b2 + hstepB, voffB); PG8_STAGE(PG8_SA(0, 0), a2, voffA);
            PG8_WAIT_V(8); PG8_WAIT_L(0); PG8_BAR; PG8_MMA(1, 0, At, B0); PG8_MMA(1, 1, At, B1); PG8_BAR; PG8_SCHED;
            PG8_LDB(B0, 1, 0); PG8_LDB(B1, 1, 1); PG8_SCHED; PG8_LDA(At, 1, 0); PG8_STAGE(PG8_SA(0, 1), a2 + hstepA, voffA);
            PG8_WAIT_V(8); PG8_WAIT_L(0); PG8_BAR; PG8_MMA(0, 0, At, B0); PG8_MMA(0, 1, At, B1); PG8_BAR; PG8_SCHED;
            PG8_LDA(At, 1, 1); PG8_STAGE(PG8_SB(1, 0), b3, voffB); PG8_STAGE(PG8_SB(1, 1), b3 + hstepB, voffB); PG8_STAGE(PG8_SA(1, 0), a3, voffA);
            PG8_WAIT_V(8); PG8_WAIT_L(0); PG8_BAR; PG8_MMA(1, 0, At, B0); PG8_MMA(1, 1, At, B1); PG8_BAR; PG8_SCHED;
            } else {
            PG8_LDB(B0, 0, 0); PG8_SCHED; PG8_LDA(At, 0, 0); PG8_STAGE(PG8_SA(1, 1), a1 + hstepA, voffA);
            PG8_WAIT_L(8); PG8_BAR; PG8_WAIT_L(0); PG8_MMA(0, 0, At, B0); PG8_BAR; PG8_SCHED;
            PG8_LDB(B1, 0, 1); PG8_STAGE(PG8_SB(0, 0), b2, voffB);
            PG8_BAR; PG8_WAIT_L(0); PG8_MMA(0, 1, At, B1); PG8_BAR;
            PG8_LDA(At, 0, 1); PG8_STAGE(PG8_SA(0, 0), a2, voffA);
            PG8_BAR; PG8_WAIT_L(0); PG8_MMA(1, 0, At, B0); PG8_BAR; PG8_SCHED;
            PG8_STAGE(PG8_SB(0, 1), b2 + hstepB, voffB);
            PG8_WAIT_V(6); PG8_BAR; PG8_MMA(1, 1, At, B1); PG8_BAR;
            PG8_LDB(B0, 1, 0); PG8_SCHED; PG8_LDA(At, 1, 0); PG8_STAGE(PG8_SA(0, 1), a2 + hstepA, voffA);
            PG8_WAIT_L(8); PG8_BAR; PG8_WAIT_L(0); PG8_MMA(0, 0, At, B0); PG8_BAR; PG8_SCHED;
            PG8_LDB(B1, 1, 1); PG8_STAGE(PG8_SB(1, 0), b3, voffB);
            PG8_BAR; PG8_WAIT_L(0); PG8_MMA(0, 1, At, B1); PG8_BAR;
            PG8_LDA(At, 1, 1); PG8_STAGE(PG8_SA(1, 0), a3, voffA);
            PG8_BAR; PG8_WAIT_L(0); PG8_MMA(1, 0, At, B0); PG8_BAR; PG8_SCHED;
            PG8_STAGE(PG8_SB(1, 1), b3 + hstepB, voffB);
            PG8_WAIT_V(6); PG8_BAR; PG8_MMA(1, 1, At, B1); PG8_BAR;
            }
        }
        if constexpr (ALIGN_EPI) { if (wr == 0) PG8_BAR; }
        if constexpr (!Epi::AFTER_DRAIN) { E(acc, cur, wr, wc, fr, fq); S.done(cur); }
        if (!has_next) break;
#pragma unroll
        for (int a = 0; a < 2; ++a)
#pragma unroll
            for (int b = 0; b < 2; ++b)
#pragma unroll
                for (int m = 0; m < 4; ++m)
#pragma unroll
                    for (int n = 0; n < 2; ++n) acc[a][b][m][n] = (f32x4){0.f, 0.f, 0.f, 0.f};
        cur = nxt; cA = nA; cB = nB; ++ui;
        if constexpr (ALIGN_EPI) { if (wr == 1) PG8_BAR; }
    }
    PG8_WAIT_V(0);
    if constexpr (!ALIGN_EPI) { if (wr == 0) PG8_BAR; }
    PG8_BAR;
    if constexpr (Epi::AFTER_DRAIN) { E.fused(acc, cur, wr, wc, fr, fq, lds, wid, lane); S.done(cur); }
#undef PG8_SA
#undef PG8_SB
#undef PG8_STAGE
#undef PG8_LDA
#undef PG8_LDB
#undef PG8_MMA
#undef PG8_WAIT_V
#undef PG8_WAIT_L
#undef PG8_BAR
#undef PG8_SCHED
}
}
namespace pg8 {
struct EpiF32 {
    static constexpr bool PERM = false, AFTER_DRAIN = false;
    float* O; int ldc;
    __device__ __forceinline__ void operator()(const f32x4 (&acc)[2][2][4][2], const Unit& u, int wr, int wc, int fr, int fq) const {
        const int row0 = u.pm * BM + wr * 64 + fr, col0 = u.pn * BM + wc * 32 + 4 * fq;
#pragma unroll
        for (int ai = 0; ai < 2; ++ai)
#pragma unroll
            for (int m = 0; m < 4; ++m) { float* rowp = O + (size_t)(row0 + ai * HALF + m * 16) * ldc + col0;
#pragma unroll
                for (int bj = 0; bj < 2; ++bj)
#pragma unroll
                    for (int n = 0; n < 2; ++n) *(f32x4*)(rowp + bj * HALF + n * 16) = acc[ai][bj][m][n]; }
    }
};
struct EpiBf16Row {
    static constexpr bool PERM = true, AFTER_DRAIN = false;
    bf16_t* O; int ldc; const float* R; int ridx;
    __device__ __forceinline__ void operator()(const f32x4 (&acc)[2][2][4][2], const Unit& u, int wr, int wc, int fr, int fq) const {
        const int row0 = u.pm * BM + wr * 64 + fr, col0 = u.pn * BM + wc * 32 + 8 * fq;
#pragma unroll
        for (int ai = 0; ai < 2; ++ai)
#pragma unroll
            for (int m = 0; m < 4; ++m) { const int r = row0 + ai * HALF + m * 16; const float sc = R[(size_t)r * 2 + ridx]; bf16_t* rowp = O + (size_t)r * ldc + col0;
#pragma unroll
                for (int bj = 0; bj < 2; ++bj) { const f32x4 v0 = acc[ai][bj][m][0] * sc, v1 = acc[ai][bj][m][1] * sc;
                    u32x4 w; w.x = cvt_pk_bf16(v0[0], v0[1]); w.y = cvt_pk_bf16(v0[2], v0[3]); w.z = cvt_pk_bf16(v1[0], v1[1]); w.w = cvt_pk_bf16(v1[2], v1[3]);
                    *(u32x4*)(rowp + bj * HALF) = w; } }
    }
};
}

namespace cg = cooperative_groups;
#define LAS __attribute__((address_space(3)))
typedef unsigned short bf16;
typedef unsigned v4u __attribute__((ext_vector_type(4)));
typedef unsigned v2u __attribute__((ext_vector_type(2)));
typedef float f32x4 __attribute__((ext_vector_type(4)));
typedef float f32x2 __attribute__((ext_vector_type(2)));

constexpr int NT = 16384, SEQ = 8192, DM = 1024, ZP = 2304, QP = 512, FF = 2816, FF2 = 5632, NCOLS = 2208;
constexpr float EPS = 1e-6f;
constexpr float LOG2E = 1.4426950408889634f;
constexpr int ZA_Q = 0, ZA_K = 256, ZA_V = 512, ZB_CQ = 768, ZB_CKV = 1024, ZB_KR = 1152, ZC_Q = 1184, ZC_K = 1440, ZC_V = 1568, ZD_Q = 1696, ZD_K = 1952, ZD_V = 2080;
constexpr size_t MiB = 1u << 20;
constexpr size_t WS_TABF = 0, WS_TABM = 2 * MiB, WS_R = 3 * MiB, WS_BAR = 3 * MiB + 512 * 1024;
constexpr size_t WS_WIN = 4 * MiB, WS_WOUT = 9 * MiB, WS_WUP = 11 * MiB, WS_WDOWN = 22 * MiB, WS_WUQ = 28 * MiB, WS_WUKV = 28 * MiB + 512 * 1024;
constexpr size_t WS_H = 29 * MiB, WS_BIG = 61 * MiB;
constexpr size_t WS_Z = WS_BIG, WS_QB = WS_BIG + 72 * MiB, WS_KVB = WS_QB + 16 * MiB, WS_MIX = WS_KVB + 16 * MiB, WS_Y = WS_BIG;
constexpr size_t WS_U = WS_BIG, WS_G = WS_BIG + 88 * MiB, WS_END = WS_G + 88 * MiB;
static_assert(WS_END <= 256 * MiB, "ws");
constexpr int LDS_BYTES = 147456;

struct Args { const float* in[19]; float* out; unsigned char* ws; };

__device__ __forceinline__ unsigned f2bf(float f) { unsigned u = __builtin_bit_cast(unsigned, f); return (u + 0x7fffu + ((u >> 16) & 1u)) >> 16; }
__device__ __forceinline__ unsigned pk2(float lo, float hi) { return f2bf(lo) | (f2bf(hi) << 16); }
__device__ __forceinline__ float bf2f(unsigned b) { return __uint_as_float(b << 16); }
__device__ __forceinline__ float bflo(unsigned w) { return __uint_as_float(w << 16); }
__device__ __forceinline__ float bfhi(unsigned w) { return __uint_as_float(w & 0xffff0000u); }
__device__ __forceinline__ float wave_sum(float v) {
#pragma unroll
    for (int o = 1; o < 64; o <<= 1) v += __shfl_xor(v, o);
    return v;
}
#define LDS_WAIT() asm volatile("s_waitcnt lgkmcnt(0)" ::: "memory")

__device__ __forceinline__ void transpose_item(const float* W, int K, int N, bf16* WT, const float* kscale, LAS float* scr, int item, int lane) {
    const int nblk = N / 32, kb = item / nblk, nb = item % nblk, k0 = 64 * kb, n0 = 32 * nb;
#pragma unroll 8
    for (int i = 0; i < 32; ++i) { const int kk = 2 * i + (lane >> 5); float w = W[(size_t)(k0 + kk) * N + n0 + (lane & 31)]; if (kscale) w *= kscale[k0 + kk]; scr[kk * 33 + (lane & 31)] = w; }
    LDS_WAIT(); asm volatile("" ::: "memory");
    const int c = lane & 7;
#pragma unroll
    for (int j = 0; j < 4; ++j) { const int n = (lane >> 3) + 8 * j; const LAS float* s = scr + (8 * c) * 33 + n;
        v4u o; o.x = pk2(s[0 * 33], s[1 * 33]); o.y = pk2(s[2 * 33], s[3 * 33]); o.z = pk2(s[4 * 33], s[5 * 33]); o.w = pk2(s[6 * 33], s[7 * 33]);
        *(v4u*)(WT + (size_t)(n0 + n) * K + k0 + 8 * c) = o; }
    LDS_WAIT(); asm volatile("" ::: "memory");
}
__device__ __forceinline__ void convert_weights(const Args& a, int l, unsigned char* ws, LAS unsigned char* lds, int gw, int NGW, int wave, int lane, int gtid, int NGT) {
    LAS float* scr = (LAS float*)(lds + wave * 16384);
    constexpr int I_IN = (DM / 64) * (NCOLS / 32), I_OUT = (DM / 64) * (DM / 32), I_UP = (DM / 64) * (FF2 / 32), I_DN = (FF / 64) * (DM / 32), I_UQ = (256 / 64) * (384 / 32), I_UKV = (128 / 64) * (512 / 32);
    constexpr int NITEMS = I_IN + I_OUT + I_UP + I_DN + I_UQ + I_UKV;
    const float* w_in = a.in[2] + (size_t)l * DM * NCOLS; const float* w_out = a.in[11] + (size_t)l * DM * DM; const float* w_up = a.in[14] + (size_t)l * DM * FF2;
    const float* w_dn = a.in[17] + (size_t)l * FF * DM; const float* w_uq = a.in[5] + (size_t)l * 256 * 384; const float* w_ukv = a.in[7] + (size_t)l * 128 * 512;
    const float* gq = a.in[4] + l * 256; const float* gkv = a.in[6] + l * 128;
    for (int it = gw; it < NITEMS; it += NGW) {
        int r = it;
        if (r < I_IN) { transpose_item(w_in, DM, NCOLS, (bf16*)(ws + WS_WIN), nullptr, scr, r, lane); continue; } r -= I_IN;
        if (r < I_OUT) { transpose_item(w_out, DM, DM, (bf16*)(ws + WS_WOUT), nullptr, scr, r, lane); continue; } r -= I_OUT;
        if (r < I_UP) { transpose_item(w_up, DM, FF2, (bf16*)(ws + WS_WUP), nullptr, scr, r, lane); continue; } r -= I_UP;
        if (r < I_DN) { transpose_item(w_dn, FF, DM, (bf16*)(ws + WS_WDOWN), nullptr, scr, r, lane); continue; } r -= I_DN;
        if (r < I_UQ) { transpose_item(w_uq, 256, 384, (bf16*)(ws + WS_WUQ), gq, scr, r, lane); continue; } r -= I_UQ;
        transpose_item(w_ukv, 128, 512, (bf16*)(ws + WS_WUKV), gkv, scr, r, lane);
    }
    { unsigned zz_ = 0u; asm volatile("" : "+v"(zz_)); v4u z = {zz_, zz_, zz_, zz_};
      v4u* p1 = (v4u*)(ws + WS_WIN + (size_t)NCOLS * DM * 2); for (int i = gtid; i < (ZP - NCOLS) * DM * 2 / 16; i += NGT) p1[i] = z;
      v4u* p2 = (v4u*)(ws + WS_WUQ + (size_t)384 * 256 * 2); for (int i = gtid; i < 128 * 256 * 2 / 16; i += NGT) p2[i] = z; }
}
__device__ __forceinline__ f32x2 cs_of(float ang) {
    const double rev = (double)ang * 0.15915494309189535; const double fr = rev - __builtin_rint(rev); const float f = (float)fr;
    f32x2 r; r.x = __builtin_amdgcn_cosf(f); r.y = __builtin_amdgcn_sinf(f); return r;
}
__device__ __forceinline__ void build_tables(unsigned char* ws, int gtid, int NGT) {
    f32x2* tf = (f32x2*)(ws + WS_TABF); f32x2* tm = (f32x2*)(ws + WS_TABM);
    for (int i = gtid; i < SEQ * 32; i += NGT) { const int t = i >> 5, k = i & 31; const float inv = (float)exp2(-(double)(2 * k) / 64.0 * 13.287712379549449); tf[i] = cs_of((float)t * inv); }
    for (int i = gtid; i < SEQ * 16; i += NGT) { const int t = i >> 4, k = i & 15; const float inv = (float)exp2(-(double)(2 * k) / 32.0 * 13.287712379549449); tm[i] = cs_of((float)t * inv); }
}
__device__ __forceinline__ void norm_row_to_bf16(const float* xrow, const float* g, bf16* orow, int lane) {
    const f32x4* xr = (const f32x4*)xrow + lane; const f32x4* gr = (const f32x4*)g + lane;
    f32x4 v[4]; float s = 0.f;
#pragma unroll
    for (int j = 0; j < 4; ++j) { v[j] = xr[64 * j]; s += (v[j].x * v[j].x + v[j].y * v[j].y) + (v[j].z * v[j].z + v[j].w * v[j].w); }
    const float r = 1.0f / sqrtf(wave_sum(s) * (1.f / DM) + EPS);
    v2u* o8 = (v2u*)orow + lane;
#pragma unroll
    for (int j = 0; j < 4; ++j) { const f32x4 gg = gr[64 * j]; v2u w; w.x = pk2(v[j].x * r * gg.x, v[j].y * r * gg.y); w.y = pk2(v[j].z * r * gg.z, v[j].w * r * gg.w); o8[64 * j] = w; }
}
__device__ __forceinline__ void resnorm_row(const float* yrow, const float* xin, const float* gpost, float* xout, const float* gnext, bf16* hrow, int lane) {
    const f32x4* yr = (const f32x4*)yrow + lane; const f32x4* xr = (const f32x4*)xin + lane; const f32x4* gp = (const f32x4*)gpost + lane; f32x4* xo = (f32x4*)xout + lane;
    f32x4 v[4]; float s = 0.f;
#pragma unroll
    for (int j = 0; j < 4; ++j) { v[j] = yr[64 * j]; s += (v[j].x * v[j].x + v[j].y * v[j].y) + (v[j].z * v[j].z + v[j].w * v[j].w); }
    const float r = 1.0f / sqrtf(wave_sum(s) * (1.f / DM) + EPS); float s2 = 0.f;
#pragma unroll
    for (int j = 0; j < 4; ++j) { const f32x4 xx = xr[64 * j], gg = gp[64 * j]; v[j] = xx + v[j] * r * gg; xo[64 * j] = v[j]; s2 += (v[j].x * v[j].x + v[j].y * v[j].y) + (v[j].z * v[j].z + v[j].w * v[j].w); }
    if (hrow) { const float r2 = 1.0f / sqrtf(wave_sum(s2) * (1.f / DM) + EPS); const f32x4* gn = (const f32x4*)gnext + lane; v2u* o8 = (v2u*)hrow + lane;
#pragma unroll
        for (int j = 0; j < 4; ++j) { const f32x4 gg = gn[64 * j]; v2u w; w.x = pk2(v[j].x * r2 * gg.x, v[j].y * r2 * gg.y); w.y = pk2(v[j].z * r2 * gg.z, v[j].w * r2 * gg.w); o8[64 * j] = w; } }
}
__device__ __forceinline__ void rope4_store(bf16* p, int i, float n0, float n1, float n2, float n3, f32x2 ta, f32x2 tb, bool axial, bool st) {
    float o0, o1, o2, o3;
    if (axial) { o0 = n0 * ta.x - n1 * ta.y; o1 = n1 * ta.x + n0 * ta.y; o2 = n2 * tb.x - n3 * tb.y; o3 = n3 * tb.x + n2 * tb.y; }
    else { o0 = n0 * ta.x - n2 * ta.y; o2 = n2 * ta.x + n0 * ta.y; o1 = n1 * tb.x - n3 * tb.y; o3 = n3 * tb.x + n1 * tb.y; }
    if (st) { p[i] = (bf16)f2bf(o0); p[16 + i] = (bf16)f2bf(o1); p[32 + i] = (bf16)f2bf(o2); p[48 + i] = (bf16)f2bf(o3); }
}
__device__ __forceinline__ void fixup_row(bf16* zr, int s, const f32x2* tabF, const f32x2* tabM, const float* gq, const float* gk, float* R2, int lane) {
    { const v2u w = *(const v2u*)(zr + ZB_CQ + 4 * lane); const float a0 = bflo(w.x), a1 = bfhi(w.x), a2 = bflo(w.y), a3 = bfhi(w.y);
      const float ss = wave_sum((a0 * a0 + a1 * a1) + (a2 * a2 + a3 * a3));
      const unsigned w2 = *(const unsigned*)(zr + ZB_CKV + 2 * lane); const float b0 = bflo(w2), b1 = bfhi(w2);
      const float ss2 = wave_sum(b0 * b0 + b1 * b1);
      if (lane == 0) { R2[0] = 1.0f / sqrtf(ss * (1.f / 256.f) + EPS); R2[1] = 1.0f / sqrtf(ss2 * (1.f / 128.f) + EPS); } }
    const int hh = lane >> 4, i = lane & 15, row = s >> 6, col = s & 63;
    const f32x2 tr = tabM[row * 16 + i], tc = tabM[col * 16 + i], tf0 = tabF[s * 32 + i], tf1 = tabF[s * 32 + 16 + i], tm = tabM[s * 16 + i];
    { const float x1 = bf2f(zr[ZB_KR + i]), x2 = bf2f(zr[ZB_KR + 16 + i]);
      if (lane < 16) { zr[ZB_KR + i] = (bf16)f2bf(x1 * tm.x - x2 * tm.y); zr[ZB_KR + 16 + i] = (bf16)f2bf(x2 * tm.x + x1 * tm.y); } }
    { bf16* p = zr + ZC_Q + hh * 64; const float e0 = bf2f(p[i]), e1 = bf2f(p[16 + i]), e2 = bf2f(p[32 + i]), e3 = bf2f(p[48 + i]);
      float ss = (e0 * e0 + e1 * e1) + (e2 * e2 + e3 * e3); ss += __shfl_xor(ss, 1); ss += __shfl_xor(ss, 2); ss += __shfl_xor(ss, 4); ss += __shfl_xor(ss, 8);
      const float r = 1.0f / sqrtf(ss * (1.f / 64.f) + EPS);
      rope4_store(p, i, e0 * r * gq[i], e1 * r * gq[16 + i], e2 * r * gq[32 + i], e3 * r * gq[48 + i], tr, tc, true, true); }
    { bf16* p = zr + ZC_K + (hh & 1) * 64; const float e0 = bf2f(p[i]), e1 = bf2f(p[16 + i]), e2 = bf2f(p[32 + i]), e3 = bf2f(p[48 + i]);
      float ss = (e0 * e0 + e1 * e1) + (e2 * e2 + e3 * e3); ss += __shfl_xor(ss, 1); ss += __shfl_xor(ss, 2); ss += __shfl_xor(ss, 4); ss += __shfl_xor(ss, 8);
      const float r = 1.0f / sqrtf(ss * (1.f / 64.f) + EPS);
      rope4_store(p, i, e0 * r * gk[i], e1 * r * gk[16 + i], e2 * r * gk[32 + i], e3 * r * gk[48 + i], tr, tc, true, lane < 32); }
    { bf16* p = zr + ZD_Q + hh * 64; const float e0 = bf2f(p[i]), e1 = bf2f(p[16 + i]), e2 = bf2f(p[32 + i]), e3 = bf2f(p[48 + i]);
      rope4_store(p, i, e0, e1, e2, e3, tf0, tf1, false, true); }
    { bf16* p = zr + ZD_K + (hh & 1) * 64; const float e0 = bf2f(p[i]), e1 = bf2f(p[16 + i]), e2 = bf2f(p[32 + i]), e3 = bf2f(p[48 + i]);
      rope4_store(p, i, e0, e1, e2, e3, tf0, tf1, false, lane < 32); }
}
__device__ __forceinline__ void unpack8(const v4u w, float* f) { f[0] = bflo(w.x); f[1] = bfhi(w.x); f[2] = bflo(w.y); f[3] = bfhi(w.y); f[4] = bflo(w.z); f[5] = bfhi(w.z); f[6] = bflo(w.w); f[7] = bfhi(w.w); }
template <int MODE> __device__ __forceinline__ void naive_attn_unit(const bf16* Z, const bf16* QB, const bf16* KVB, bf16* MIX, const f32x2* tabM, const float* rpb, const float* sink,
                                                                     int b, int head, int qblk, LAS unsigned char* lds, int tid) {
    constexpr int DQ = (MODE == 1) ? 96 : 64;
    LAS float* Ks = (LAS float*)lds; LAS float* Vs = Ks + 64 * DQ; LAS float* Bs = Vs + 64 * 64;
    const int s = qblk * 512 + tid; const size_t t = (size_t)b * SEQ + s; const size_t tb = (size_t)b * SEQ;
    const bf16* qp; const bf16* Ksrc; const bf16* Vsrc; int kp, vp; float scale;
    if (MODE == 0) { qp = Z + t * ZP + ZA_Q + head * 64; Ksrc = Z + tb * ZP + ZA_K + head * 64; Vsrc = Z + tb * ZP + ZA_V + head * 64; kp = ZP; vp = ZP; scale = 0.125f; }
    else if (MODE == 1) { qp = QB + t * QP + head * 96; Ksrc = KVB + tb * QP + head * 128; Vsrc = KVB + tb * QP + head * 128 + 64; kp = QP; vp = QP; scale = 0.10206207261596577f; }
    else if (MODE == 2) { qp = Z + t * ZP + ZC_Q + head * 64; Ksrc = Z + tb * ZP + ZC_K + (head >> 1) * 64; Vsrc = Z + tb * ZP + ZC_V + (head >> 1) * 64; kp = ZP; vp = ZP; scale = 0.125f; }
    else { qp = Z + t * ZP + ZD_Q + head * 64; Ksrc = Z + tb * ZP + ZD_K + (head >> 1) * 64; Vsrc = Z + tb * ZP + ZD_V + (head >> 1) * 64; kp = ZP; vp = ZP; scale = 0.125f; }
    const bf16* K2src = Z + tb * ZP + ZB_KR;
    const float c2 = scale * LOG2E;
    float q[DQ];
#pragma unroll
    for (int d = 0; d < DQ; d += 8) unpack8(*(const v4u*)(qp + d), q + d);
    if (MODE == 1) {
#pragma unroll
        for (int i = 0; i < 16; ++i) { const f32x2 cs = tabM[s * 16 + i]; const float x1 = q[64 + i], x2 = q[80 + i]; q[64 + i] = x1 * cs.x - x2 * cs.y; q[80 + i] = x2 * cs.x + x1 * cs.y; }
    }
    int lo = 0, hi = 128;
    const int r = s >> 6, c = s & 63;
    const int rs = min(max(r - 4, 0), 120), cs0 = min(max(c - 8, 0), 48);
    if (MODE == 0) { const int r0 = qblk * 8; lo = min(max(r0 - 4, 0), 120); hi = min(max(r0 + 7 - 4, 0), 120) + 8; __syncthreads(); if (tid < 465) Bs[tid] = rpb[head * 465 + tid] * LOG2E; }
    if (MODE == 3) { lo = max(qblk * 8 - 2, 0); hi = min(qblk * 8 + 10, 128); }
    float m = -1e30f, l = 0.f; float o[64];
#pragma unroll
    for (int d = 0; d < 64; ++d) o[d] = 0.f;
    if (MODE == 3) { m = sink[head] * LOG2E; l = 1.f; }
    for (int kt = lo; kt < hi; ++kt) {
        __syncthreads();
        { const int j = tid >> 3, ch = tid & 7; float f[8];
          unpack8(*(const v4u*)(Ksrc + (size_t)(kt * 64 + j) * kp + ch * 8), f);
          *(LAS f32x4*)(Ks + j * DQ + ch * 8) = (f32x4){f[0], f[1], f[2], f[3]}; *(LAS f32x4*)(Ks + j * DQ + ch * 8 + 4) = (f32x4){f[4], f[5], f[6], f[7]};
          unpack8(*(const v4u*)(Vsrc + (size_t)(kt * 64 + j) * vp + ch * 8), f);
          *(LAS f32x4*)(Vs + j * 64 + ch * 8) = (f32x4){f[0], f[1], f[2], f[3]}; *(LAS f32x4*)(Vs + j * 64 + ch * 8 + 4) = (f32x4){f[4], f[5], f[6], f[7]};
          if (MODE == 1 && tid < 256) { const int j2 = tid >> 2, c2i = tid & 3; unpack8(*(const v4u*)(K2src + (size_t)(kt * 64 + j2) * ZP + c2i * 8), f);
            *(LAS f32x4*)(Ks + j2 * DQ + 64 + c2i * 8) = (f32x4){f[0], f[1], f[2], f[3]}; *(LAS f32x4*)(Ks + j2 * DQ + 64 + c2i * 8 + 4) = (f32x4){f[4], f[5], f[6], f[7]}; } }
        __syncthreads();
        const bool rowok = (MODE != 0) || (kt >= rs && kt < rs + 8);
        if (rowok) {
            for (int j = 0; j < 64; ++j) {
                bool valid = true;
                if (MODE == 0) valid = (j >= cs0 && j < cs0 + 16);
                if (MODE == 3) { const int d = s - (kt * 64 + j); valid = (d <= 128 && d >= -128); }
                if (valid) {
                    float a0 = 0.f, a1 = 0.f, a2 = 0.f, a3 = 0.f;
#pragma unroll
                    for (int d = 0; d < DQ; d += 4) { const f32x4 k4 = *(const LAS f32x4*)(Ks + j * DQ + d); a0 += q[d] * k4.x; a1 += q[d + 1] * k4.y; a2 += q[d + 2] * k4.z; a3 += q[d + 3] * k4.w; }
                    float s2 = ((a0 + a1) + (a2 + a3)) * c2;
                    if (MODE == 0) s2 += Bs[(kt - r + 7) * 31 + (j - c + 15)];
                    if (s2 > m) { const float al = __builtin_amdgcn_exp2f(m - s2); l *= al;
#pragma unroll
                        for (int d = 0; d < 64; ++d) o[d] *= al;
                        m = s2; }
                    const float p = __builtin_amdgcn_exp2f(s2 - m); l += p;
#pragma unroll
                    for (int d = 0; d < 64; d += 4) { const f32x4 v4 = *(const LAS f32x4*)(Vs + j * 64 + d); o[d] += p * v4.x; o[d + 1] += p * v4.y; o[d + 2] += p * v4.z; o[d + 3] += p * v4.w; }
                }
            }
        }
    }
    const float inv = 1.0f / l;
    bf16* op = MIX + t * DM + MODE * 256 + head * 64;
#pragma unroll
    for (int d = 0; d < 64; d += 8) { v4u w; w.x = pk2(o[d] * inv, o[d + 1] * inv); w.y = pk2(o[d + 2] * inv, o[d + 3] * inv); w.z = pk2(o[d + 4] * inv, o[d + 5] * inv); w.w = pk2(o[d + 6] * inv, o[d + 7] * inv); *(v4u*)(op + d) = w; }
}

typedef short bf16x8_t __attribute__((ext_vector_type(8)));
typedef short s16x4_t __attribute__((ext_vector_type(4)));
typedef float f32x16 __attribute__((ext_vector_type(16)));
__device__ __forceinline__ int crow(int r, int hi) { return (r & 3) + 8 * (r >> 2) + 4 * hi; }
__device__ __forceinline__ s16x4_t vtr(const LAS unsigned char* p) { return __builtin_bit_cast(s16x4_t, __builtin_amdgcn_ds_read_tr16_b64_v4i16((LAS s16x4_t*)p)); }
__device__ __forceinline__ unsigned cvtpk(float lo, float hi) { typedef float f2 __attribute__((ext_vector_type(2))); typedef __bf16 b2 __attribute__((ext_vector_type(2))); f2 v = {lo, hi}; b2 b = __builtin_convertvector(v, b2); return __builtin_bit_cast(unsigned, b); }
__device__ __forceinline__ float max3f_(float a, float b, float c) { float r; asm("v_max3_f32 %0, %1, %2, %3" : "=v"(r) : "v"(a), "v"(b), "v"(c)); return r; }
__device__ __forceinline__ float fadd_s_(float a, float b) { float r; asm("v_add_f32_e32 %0, %1, %2" : "=v"(r) : "v"(a), "v"(b)); return r; }
template <int MODE> __device__ __forceinline__ void fa_unit(const bf16* Zp, const bf16* QBp, const bf16* KVBp, bf16* MIXp, const f32x2* tabMp, const float* rpb, const float* sink,
                                                             int b, int head, int qblk, LAS unsigned char* lds, int tid) {
    asm volatile("" : "+v"(tid));
    constexpr int DQ = (MODE == 1) ? 96 : 64, NC = DQ / 16, PK = DQ * 2 + 16, PV = 192, KBYTES = 64 * PK, VBYTES = 64 * PV, BUF = KBYTES + VBYTES;
    constexpr float THR = 4.0f;
    const int lane = tid & 63, wave = __builtin_amdgcn_readfirstlane(tid >> 6), r32 = lane & 31, hi = lane >> 5;
    LAS float* wsf = (LAS float*)(lds + 2 * BUF) + wave * 32; LAS float* Bs = (LAS float*)(lds + 2 * BUF + 8 * 32 * 4);
    const int q0 = qblk * 256, w0 = q0 + wave * 32, sq = w0 + r32; const size_t tb = (size_t)b * SEQ, t = tb + sq;
    const bf16* qp; const bf16* Ksrc; const bf16* Vsrc; int kp, vp; float scale;
    if (MODE == 0) { qp = Zp + t * ZP + ZA_Q + head * 64; Ksrc = Zp + tb * ZP + ZA_K + head * 64; Vsrc = Zp + tb * ZP + ZA_V + head * 64; kp = ZP; vp = ZP; scale = 0.125f; }
    else if (MODE == 1) { qp = QBp + t * QP + head * 96; Ksrc = KVBp + tb * QP + head * 128; Vsrc = KVBp + tb * QP + head * 128 + 64; kp = QP; vp = QP; scale = 0.10206207261596577f; }
    else if (MODE == 2) { qp = Zp + t * ZP + ZC_Q + head * 64; Ksrc = Zp + tb * ZP + ZC_K + (head >> 1) * 64; Vsrc = Zp + tb * ZP + ZC_V + (head >> 1) * 64; kp = ZP; vp = ZP; scale = 0.125f; }
    else { qp = Zp + t * ZP + ZD_Q + head * 64; Ksrc = Zp + tb * ZP + ZD_K + (head >> 1) * 64; Vsrc = Zp + tb * ZP + ZD_V + (head >> 1) * 64; kp = ZP; vp = ZP; scale = 0.125f; }
    const bf16* K2src = Zp + tb * ZP + ZB_KR;
    const float c2 = scale * LOG2E;
    bf16x8_t qf[NC];
#pragma unroll
    for (int c = 0; c < NC; ++c) qf[c] = *(const bf16x8_t*)(qp + 16 * c + 8 * hi);
    if (MODE == 1) {
#pragma unroll
        for (int j = 0; j < 8; ++j) { const f32x2 cs = tabMp[sq * 16 + 8 * hi + j]; const float x1 = bf2f((unsigned short)qf[NC - 2][j]), x2 = bf2f((unsigned short)qf[NC - 1][j]);
            qf[NC - 2][j] = (short)f2bf(x1 * cs.x - x2 * cs.y); qf[NC - 1][j] = (short)f2bf(x2 * cs.x + x1 * cs.y); }
    }
    int lo = 0, hit = 128;
    const int rw = w0 >> 6, rs = min(max(rw - 4, 0), 120), cq = sq & 63, cs0 = min(max(cq - 8, 0), 48);
    if (MODE == 0) { const int r0 = qblk * 4; lo = min(max(r0 - 4, 0), 120); hit = min(max(r0 + 3 - 4, 0), 120) + 8; if (tid < 465) Bs[tid] = rpb[head * 465 + tid] * LOG2E; }
    if (MODE == 3) { lo = max(qblk * 4 - 2, 0); hit = min(qblk * 4 + 6, 128); }
    f32x16 o0, o1;
#pragma unroll
    for (int r = 0; r < 16; ++r) { o0[r] = 0.f; o1[r] = 0.f; }
    float mref = -1e30f, l = 0.f;
    if (MODE == 3) { mref = sink[head] * LOG2E; l = (hi == 0) ? 1.f : 0.f; }
    v4u kreg, vreg, k2reg = {0u, 0u, 0u, 0u};
#define FA_GLOAD(kt) do { kreg = *(const v4u*)(Ksrc + (size_t)((kt) * 64 + (tid >> 3)) * kp + (tid & 7) * 8); vreg = *(const v4u*)(Vsrc + (size_t)((kt) * 64 + (tid >> 3)) * vp + (tid & 7) * 8); \
        if (MODE == 1 && tid < 256) k2reg = *(const v4u*)(K2src + (size_t)((kt) * 64 + (tid >> 2)) * ZP + (tid & 3) * 8); } while (0)
#define FA_LSTORE(buf) do { *(LAS v4u*)(lds + (buf) * BUF + (tid >> 3) * PK + (tid & 7) * 16) = kreg; *(LAS v4u*)(lds + (buf) * BUF + KBYTES + (tid >> 3) * PV + (tid & 7) * 16) = vreg; \
        if (MODE == 1 && tid < 256) *(LAS v4u*)(lds + (buf) * BUF + (tid >> 2) * PK + 128 + (tid & 3) * 16) = k2reg; } while (0)
    FA_GLOAD(lo); FA_LSTORE(lo & 1);
    __syncthreads();
    for (int kt = lo; kt < hit; ++kt) {
        const bool more = (kt + 1 < hit);
        if (more) FA_GLOAD(kt + 1);
        bool rel = true;
        if (MODE == 0) rel = (kt >= rs && kt < rs + 8);
        if (MODE == 3) rel = (kt * 64 + 63 >= w0 - 128) && (kt * 64 <= w0 + 31 + 128);
        if (rel) {
            const LAS unsigned char* Kb = lds + (kt & 1) * BUF; const LAS unsigned char* Vb = Kb + KBYTES;
            f32x16 p0, p1;
#pragma unroll
            for (int r = 0; r < 16; ++r) { p0[r] = 0.f; p1[r] = 0.f; }
#pragma unroll
            for (int c = 0; c < NC; ++c) {
                const bf16x8_t kA0 = *(const LAS bf16x8_t*)(Kb + r32 * PK + c * 32 + hi * 16);
                const bf16x8_t kA1 = *(const LAS bf16x8_t*)(Kb + (32 + r32) * PK + c * 32 + hi * 16);
                p0 = __builtin_amdgcn_mfma_f32_32x32x16_bf16(kA0, qf[c], p0, 0, 0, 0);
                p1 = __builtin_amdgcn_mfma_f32_32x32x16_bf16(kA1, qf[c], p1, 0, 0, 0);
            }
            float mx = -3e38f;
            if (MODE == 1 || MODE == 2) {
#pragma unroll
                for (int r = 0; r < 16; ++r) mx = fmaxf(mx, fmaxf(p0[r], p1[r]));
                mx *= c2;
            } else if (MODE == 0) {
#pragma unroll
                for (int r = 0; r < 16; ++r) { const int j0 = crow(r, hi), j1 = j0 + 32; const bool v0 = (j0 >= cs0 && j0 < cs0 + 16), v1 = (j1 >= cs0 && j1 < cs0 + 16);
                    const int i0 = v0 ? (kt - rw + 7) * 31 + (j0 - cq + 15) : 0, i1 = v1 ? (kt - rw + 7) * 31 + (j1 - cq + 15) : 0;
                    const float s0 = v0 ? (p0[r] * c2 + Bs[i0]) : -1e30f, s1 = v1 ? (p1[r] * c2 + Bs[i1]) : -1e30f;
                    p0[r] = s0; p1[r] = s1; mx = fmaxf(mx, fmaxf(s0, s1)); }
            } else {
#pragma unroll
                for (int r = 0; r < 16; ++r) { const int d0 = sq - (kt * 64 + crow(r, hi)), d1 = d0 - 32; const bool v0 = (d0 <= 128 && d0 >= -128), v1 = (d1 <= 128 && d1 >= -128);
                    const float s0 = v0 ? p0[r] * c2 : -1e30f, s1 = v1 ? p1[r] * c2 : -1e30f; p0[r] = s0; p1[r] = s1; mx = fmaxf(mx, fmaxf(s0, s1)); }
            }
            mx = fmaxf(mx, __shfl_xor(mx, 32));
            if (__any(mx > mref + THR)) {
                const float mnew = fmaxf(mref, mx); const float alpha = __builtin_amdgcn_exp2f(mref - mnew); mref = mnew; l *= alpha;
                if (hi == 0) wsf[r32] = alpha;
#pragma unroll
                for (int r = 0; r < 16; ++r) { const float a = wsf[crow(r, hi)]; o0[r] *= a; o1[r] *= a; }
            }
            float ps = 0.f;
            if (MODE == 1 || MODE == 2) {
#pragma unroll
                for (int r = 0; r < 16; ++r) { p0[r] = __builtin_amdgcn_exp2f(p0[r] * c2 - mref); p1[r] = __builtin_amdgcn_exp2f(p1[r] * c2 - mref); ps += p0[r] + p1[r]; }
            } else {
#pragma unroll
                for (int r = 0; r < 16; ++r) { p0[r] = __builtin_amdgcn_exp2f(p0[r] - mref); p1[r] = __builtin_amdgcn_exp2f(p1[r] - mref); ps += p0[r] + p1[r]; }
            }
            l += ps;
            v4u pw[4];
            pw[0] = (v4u){cvtpk(p0[0], p0[1]), cvtpk(p0[2], p0[3]), cvtpk(p0[4], p0[5]), cvtpk(p0[6], p0[7])};
            pw[1] = (v4u){cvtpk(p0[8], p0[9]), cvtpk(p0[10], p0[11]), cvtpk(p0[12], p0[13]), cvtpk(p0[14], p0[15])};
            pw[2] = (v4u){cvtpk(p1[0], p1[1]), cvtpk(p1[2], p1[3]), cvtpk(p1[4], p1[5]), cvtpk(p1[6], p1[7])};
            pw[3] = (v4u){cvtpk(p1[8], p1[9]), cvtpk(p1[10], p1[11]), cvtpk(p1[12], p1[13]), cvtpk(p1[14], p1[15])};
            const LAS unsigned char* vbase = Vb + (4 * hi + ((lane & 15) >> 2)) * PV + (16 * ((lane >> 4) & 1) + 4 * (lane & 3)) * 2;
#pragma unroll
            for (int s4 = 0; s4 < 4; ++s4) {
                const bf16x8_t pa = __builtin_bit_cast(bf16x8_t, pw[s4]);
#pragma unroll
                for (int db = 0; db < 2; ++db) {
                    const LAS unsigned char* ad = vbase + (32 * (s4 >> 1) + 16 * (s4 & 1)) * PV + db * 64;
                    const s16x4_t t0 = vtr(ad), t1 = vtr(ad + 8 * PV);
                    const bf16x8_t vB = {t0[0], t0[1], t0[2], t0[3], t1[0], t1[1], t1[2], t1[3]};
                    if (db == 0) o0 = __builtin_amdgcn_mfma_f32_32x32x16_bf16(pa, vB, o0, 0, 0, 0); else o1 = __builtin_amdgcn_mfma_f32_32x32x16_bf16(pa, vB, o1, 0, 0, 0);
                }
            }
        }
        if (more) FA_LSTORE((kt + 1) & 1);
        __syncthreads();
    }
#undef FA_GLOAD
#undef FA_LSTORE
    l += __shfl_xor(l, 32);
    if (hi == 0) wsf[r32] = 1.0f / l;
    bf16* op = MIXp + (tb + w0) * DM + MODE * 256 + head * 64 + r32;
#pragma unroll
    for (int r = 0; r < 16; ++r) { const int row = crow(r, hi); const float il = wsf[row]; op[(size_t)row * DM] = (bf16)f2bf(o0[r] * il); op[(size_t)row * DM + 32] = (bf16)f2bf(o1[r] * il); }
}

template <int MODE> __device__ __forceinline__ void fa_dense_sp(const bf16* Zp, const bf16* QBp, const bf16* KVBp, bf16* MIXp, const f32x2* tabMp,
                                                                 int b, int head, int qblk, LAS unsigned char* lds, int tid) {
    asm volatile("" : "+v"(tid));
    constexpr int DQ = (MODE == 1) ? 96 : 64, NC = DQ / 16, PK = DQ * 2 + 16, PV = 192, KBYTES = 64 * PK, VBYTES = 64 * PV, VOFF = 2 * KBYTES, WOFF = VOFF + 2 * VBYTES;
    constexpr float THR = 4.0f;
    const int lane = tid & 63, wave = __builtin_amdgcn_readfirstlane(tid >> 6), r32 = lane & 31, hi = lane >> 5;
    LAS float* wsf = (LAS float*)(lds + WOFF) + wave * 32;
    const int q0 = qblk * 256, w0 = q0 + wave * 32, sq = w0 + r32; const size_t tb = (size_t)b * SEQ;
    const bf16* qp; const bf16* Ksrc; const bf16* Vsrc; int kp, vp; float scale;
    if (MODE == 1) { qp = QBp + (tb + sq) * QP + head * 96; Ksrc = KVBp + tb * QP + head * 128; Vsrc = KVBp + tb * QP + head * 128 + 64; kp = QP; vp = QP; scale = 0.10206207261596577f; }
    else { qp = Zp + (tb + sq) * ZP + ZC_Q + head * 64; Ksrc = Zp + tb * ZP + ZC_K + (head >> 1) * 64; Vsrc = Zp + tb * ZP + ZC_V + (head >> 1) * 64; kp = ZP; vp = ZP; scale = 0.125f; }
    const float c2 = scale * LOG2E;
    bf16x8_t qf[NC];
#pragma unroll
    for (int c = 0; c < NC; ++c) qf[c] = *(const bf16x8_t*)(qp + 16 * c + 8 * hi);
    if (MODE == 1) {
#pragma unroll
        for (int j = 0; j < 8; ++j) { const f32x2 cs = tabMp[sq * 16 + 8 * hi + j]; const float x1 = bf2f((unsigned short)qf[NC - 2][j]), x2 = bf2f((unsigned short)qf[NC - 1][j]);
            qf[NC - 2][j] = (short)f2bf(x1 * cs.x - x2 * cs.y); qf[NC - 1][j] = (short)f2bf(x2 * cs.x + x1 * cs.y); }
    }
    const bf16* kg = Ksrc + (size_t)(tid >> 3) * kp + (tid & 7) * 8; const bf16* vg = Vsrc + (size_t)(tid >> 3) * vp + (tid & 7) * 8;
    const bf16* k2g = Zp + tb * ZP + ZB_KR + (size_t)((tid >> 2) & 63) * ZP + (tid & 3) * 8;
    LAS unsigned char* kst = lds + (tid >> 3) * PK + (tid & 7) * 16; LAS unsigned char* k2st = lds + ((tid >> 2) & 63) * PK + 128 + (tid & 3) * 16; LAS unsigned char* vst = lds + VOFF + (tid >> 3) * PV + (tid & 7) * 16;
    const LAS unsigned char* kbase = lds + r32 * PK + hi * 16;
    const LAS unsigned char* vbase = lds + VOFF + (4 * hi + ((lane & 15) >> 2)) * PV + (16 * ((lane >> 4) & 1) + 4 * (lane & 3)) * 2;
    f32x16 o0, o1, pa0, pa1, pb0, pb1;
#pragma unroll
    for (int r = 0; r < 16; ++r) { o0[r] = 0.f; o1[r] = 0.f; }
    float mref = -1e30f, l = 0.f; bool resc = false;
    v4u kreg, vreg, k2reg = {0u, 0u, 0u, 0u}, pw[4]; bf16x8_t kf[2 * NC];
    const bool k2t = (MODE == 1) && (tid < 256);
#define P3_LDK(kt) do { kreg = *(const v4u*)(kg + (size_t)(kt) * 64 * kp); if (k2t) k2reg = *(const v4u*)(k2g + (size_t)(kt) * 64 * ZP); } while (0)
#define P3_LDV(kt) do { vreg = *(const v4u*)(vg + (size_t)(kt) * 64 * vp); } while (0)
#define P3_STK(par) do { *(LAS v4u*)(kst + (par) * KBYTES) = kreg; if (k2t) *(LAS v4u*)(k2st + (par) * KBYTES) = k2reg; } while (0)
#define P3_STV(par) do { *(LAS v4u*)(vst + (par) * VBYTES) = vreg; } while (0)
#define P3_RDKF(par) do { _Pragma("unroll") for (int c = 0; c < NC; ++c) { kf[2 * c] = *(const LAS bf16x8_t*)(kbase + (par) * KBYTES + c * 32); kf[2 * c + 1] = *(const LAS bf16x8_t*)(kbase + (par) * KBYTES + 32 * PK + c * 32); } } while (0)
#define P3_QK(P0, P1) do { const f32x16 z_ = {0.f, 0.f, 0.f, 0.f, 0.f, 0.f, 0.f, 0.f, 0.f, 0.f, 0.f, 0.f, 0.f, 0.f, 0.f, 0.f}; \
        P0 = __builtin_amdgcn_mfma_f32_32x32x16_bf16(kf[0], qf[0], z_, 0, 0, 0); P1 = __builtin_amdgcn_mfma_f32_32x32x16_bf16(kf[1], qf[0], z_, 0, 0, 0); \
        _Pragma("unroll") for (int c = 1; c < NC; ++c) { P0 = __builtin_amdgcn_mfma_f32_32x32x16_bf16(kf[2 * c], qf[c], P0, 0, 0, 0); P1 = __builtin_amdgcn_mfma_f32_32x32x16_bf16(kf[2 * c + 1], qf[c], P1, 0, 0, 0); } } while (0)
#define P3_DECIDE(P0, P1) do { asm volatile("s_nop 15\n\ts_nop 7" : "+v"(P0), "+v"(P1));     \
        float ma_ = max3f_(P0[0], P0[1], P1[0]), mb_ = max3f_(P0[2], P0[3], P1[1]); ma_ = max3f_(ma_, P1[2], P1[3]); \
        _Pragma("unroll") for (int r = 4; r < 16; r += 4) { ma_ = max3f_(ma_, P0[r], P0[r + 1]); mb_ = max3f_(mb_, P0[r + 2], P0[r + 3]); ma_ = max3f_(ma_, P1[r], P1[r + 1]); mb_ = max3f_(mb_, P1[r + 2], P1[r + 3]); } \
        float m_ = max3f_(ma_, mb_, mb_) * c2; \
        { const auto rr_ = __builtin_amdgcn_permlane32_swap(__float_as_uint(m_), __float_as_uint(m_), false, false); m_ = fmaxf(__uint_as_float(rr_[0]), __uint_as_float(rr_[1])); } \
        resc = false; if (__any(m_ > mref + THR)) { const float mnew_ = fmaxf(mref, m_); const float al_ = __builtin_amdgcn_exp2f(mref - mnew_); mref = mnew_; l *= al_; if (hi == 0) wsf[r32] = al_; resc = true; } } while (0)
#define P3_PV(par) do { const LAS unsigned char* vb_ = vbase + (par) * VBYTES; \
        _Pragma("unroll") for (int s4 = 0; s4 < 4; ++s4) { const bf16x8_t pa_ = __builtin_bit_cast(bf16x8_t, pw[s4]); \
            _Pragma("unroll") for (int db = 0; db < 2; ++db) { const LAS unsigned char* ad_ = vb_ + (32 * (s4 >> 1) + 16 * (s4 & 1)) * PV + db * 64; const s16x4_t t0_ = vtr(ad_), t1_ = vtr(ad_ + 8 * PV); \
                const bf16x8_t vB_ = {t0_[0], t0_[1], t0_[2], t0_[3], t1_[0], t1_[1], t1_[2], t1_[3]}; \
                if (db == 0) o0 = __builtin_amdgcn_mfma_f32_32x32x16_bf16(pa_, vB_, o0, 0, 0, 0); else o1 = __builtin_amdgcn_mfma_f32_32x32x16_bf16(pa_, vB_, o1, 0, 0, 0); } } } while (0)
#define P3_SOFT(P0, P1) do { float psa_ = 0.f, psb_ = 0.f; _Pragma("unroll") for (int r = 0; r < 16; ++r) { P0[r] = __builtin_amdgcn_exp2f(P0[r] * c2 - mref); P1[r] = __builtin_amdgcn_exp2f(P1[r] * c2 - mref); psa_ += P0[r]; psa_ += P1[r]; } l += psa_ + psb_; \
        pw[0] = (v4u){cvtpk(P0[0], P0[1]), cvtpk(P0[2], P0[3]), cvtpk(P0[4], P0[5]), cvtpk(P0[6], P0[7])}; pw[1] = (v4u){cvtpk(P0[8], P0[9]), cvtpk(P0[10], P0[11]), cvtpk(P0[12], P0[13]), cvtpk(P0[14], P0[15])}; \
        pw[2] = (v4u){cvtpk(P1[0], P1[1]), cvtpk(P1[2], P1[3]), cvtpk(P1[4], P1[5]), cvtpk(P1[6], P1[7])}; pw[3] = (v4u){cvtpk(P1[8], P1[9]), cvtpk(P1[10], P1[11]), cvtpk(P1[12], P1[13]), cvtpk(P1[14], P1[15])}; } while (0)
#define P3_RESC() do { if (resc) { _Pragma("unroll") for (int r = 0; r < 16; ++r) { const float a_ = wsf[crow(r, hi)]; o0[r] *= a_; o1[r] *= a_; } } } while (0)
#define P3_HINT_X() do { _Pragma("unroll") for (int g_ = 0; g_ < 2 * NC; ++g_) { __builtin_amdgcn_sched_group_barrier(0x008, 1, 0); __builtin_amdgcn_sched_group_barrier(0x002, (NC == 4) ? 14 : 9, 0); } } while (0)
#define P3_STEP(s, PAR, PC0, PC1, PN0, PN1, HASK3, HASK4, HASV1, HASV2, HASQK, HASKF) do { \
        if (HASK3) P3_STK(1 - (PAR)); if (HASV1) P3_STV(1 - (PAR)); if (HASK4) P3_LDK((s) + 4); if (HASV2) P3_LDV((s) + 2); \
        if (HASQK) { P3_QK(PN0, PN1); P3_SOFT(PC0, PC1); P3_HINT_X(); } else { P3_SOFT(PC0, PC1); } \
        P3_PV(PAR); if (HASQK) P3_DECIDE(PN0, PN1); else resc = false; if (HASKF) P3_RDKF(PAR); P3_RESC(); \
        __syncthreads(); } while (0)
    P3_LDK(0); P3_STK(0); P3_LDK(1); P3_STK(1); P3_LDV(0); P3_STV(0);
    __syncthreads();
    P3_RDKF(0); P3_LDK(2);
    P3_QK(pa0, pa1); P3_DECIDE(pa0, pa1); P3_RDKF(1);
    __syncthreads();
    P3_STK(0); P3_LDK(3); P3_LDV(1);
    __syncthreads();
#pragma unroll 1
    for (int s = 0; s <= 122; s += 2) { P3_STEP(s, 0, pa0, pa1, pb0, pb1, true, true, true, true, true, true); P3_STEP(s + 1, 1, pb0, pb1, pa0, pa1, true, true, true, true, true, true); }
    P3_STEP(124, 0, pa0, pa1, pb0, pb1, true, false, true, true, true, true);
    P3_STEP(125, 1, pb0, pb1, pa0, pa1, false, false, true, true, true, true);
    P3_STEP(126, 0, pa0, pa1, pb0, pb1, false, false, true, false, true, false);
    P3_STEP(127, 1, pb0, pb1, pa0, pa1, false, false, false, false, false, false);
#undef P3_LDK
#undef P3_LDV
#undef P3_STK
#undef P3_STV
#undef P3_RDKF
#undef P3_QK
#undef P3_DECIDE
#undef P3_PV
#undef P3_SOFT
#undef P3_RESC
#undef P3_HINT_X
#undef P3_STEP
    l += __shfl_xor(l, 32);
    if (hi == 0) wsf[r32] = 1.0f / l;
    bf16* op = MIXp + (tb + w0) * DM + MODE * 256 + head * 64 + r32;
#pragma unroll
    for (int r = 0; r < 16; ++r) { const int row = crow(r, hi); const float il = wsf[row]; op[(size_t)row * DM] = (bf16)f2bf(o0[r] * il); op[(size_t)row * DM + 32] = (bf16)f2bf(o1[r] * il); }
}
__device__ __forceinline__ float gelu_tanh(float x) {
    const float z = 0.7978845608028654f * (x + 0.044715f * x * x * x);
    const float e = __builtin_amdgcn_exp2f(z * (2.0f * LOG2E));
    const float th = 1.0f - 2.0f * __builtin_amdgcn_rcpf(e + 1.0f);
    return 0.5f * x * (1.0f + th);
}
__device__ __forceinline__ void conv_phase(const bf16* U, bf16* Gout  , const float* cw, const float* cb, int gtid, int NGT) {
    constexpr int CG = FF / 8, RC = 16;
    for (int item = gtid; item < (SEQ / RC) * CG; item += NGT) {
        const int cgi = item % CG, rc = item / CG, n = cgi * 8, s0 = rc * RC;
        float wg[3][8], wv[3][8], bg[8], bv[8];
#pragma unroll
        for (int i = 0; i < 3; ++i) {
#pragma unroll
            for (int e = 0; e < 8; e += 4) { const f32x4 a = *(const f32x4*)(cw + (size_t)i * FF2 + n + e), bq = *(const f32x4*)(cw + (size_t)i * FF2 + FF + n + e);
                wg[i][e] = a.x; wg[i][e + 1] = a.y; wg[i][e + 2] = a.z; wg[i][e + 3] = a.w; wv[i][e] = bq.x; wv[i][e + 1] = bq.y; wv[i][e + 2] = bq.z; wv[i][e + 3] = bq.w; } }
#pragma unroll
        for (int e = 0; e < 8; e += 4) { const f32x4 a = *(const f32x4*)(cb + n + e), bq = *(const f32x4*)(cb + FF + n + e);
            bg[e] = a.x; bg[e + 1] = a.y; bg[e + 2] = a.z; bg[e + 3] = a.w; bv[e] = bq.x; bv[e + 1] = bq.y; bv[e + 2] = bq.z; bv[e + 3] = bq.w; }
        float pg[8], pv[8], cgv[8], cv[8], ng[8], nv[8];
        if (s0 > 0) { unpack8(*(const v4u*)(U + (size_t)(s0 - 1) * FF2 + n), pg); unpack8(*(const v4u*)(U + (size_t)(s0 - 1) * FF2 + FF + n), pv); }
        else {
#pragma unroll
            for (int e = 0; e < 8; ++e) { pg[e] = 0.f; pv[e] = 0.f; } }
        unpack8(*(const v4u*)(U + (size_t)s0 * FF2 + n), cgv); unpack8(*(const v4u*)(U + (size_t)s0 * FF2 + FF + n), cv);
        for (int rr = 0; rr < RC; ++rr) {
            const int s = s0 + rr;
            if (s + 1 < SEQ) { unpack8(*(const v4u*)(U + (size_t)(s + 1) * FF2 + n), ng); unpack8(*(const v4u*)(U + (size_t)(s + 1) * FF2 + FF + n), nv); }
            else {
#pragma unroll
                for (int e = 0; e < 8; ++e) { ng[e] = 0.f; nv[e] = 0.f; } }
            float res[8];
#pragma unroll
            for (int e = 0; e < 8; ++e) { const float gate = bg[e] + pg[e] * wg[0][e] + cgv[e] * wg[1][e] + ng[e] * wg[2][e]; const float val = bv[e] + pv[e] * wv[0][e] + cv[e] * wv[1][e] + nv[e] * wv[2][e];
                res[e] = gelu_tanh(gate) * val; }
            v4u w; w.x = pk2(res[0], res[1]); w.y = pk2(res[2], res[3]); w.z = pk2(res[4], res[5]); w.w = pk2(res[6], res[7]);
            *(v4u*)(Gout + (size_t)s * FF + n) = w;
#pragma unroll
            for (int e = 0; e < 8; ++e) { pg[e] = cgv[e]; pv[e] = cv[e]; cgv[e] = ng[e]; cv[e] = nv[e]; }
        }
    }
}

#define RLX_AGENT __ATOMIC_RELAXED, __HIP_MEMORY_SCOPE_AGENT
#define XB_TMO      128
#define XB_XCNT(j)  (256  + 64 * (j))
#define XB_XSUB(j)  (1280 + 64 * (j))
#define XB_XGEN(j)  (2304 + 64 * (j))
#define XB_TOP      3328
#define XB_TOPGEN   3392
#define XCD_BAR_WORDS 3456
#define XB_SPIN_CAP (1u << 18)

__device__ __forceinline__ unsigned xb_ld(unsigned* p)              { return __hip_atomic_load(p, __ATOMIC_RELAXED, __HIP_MEMORY_SCOPE_AGENT); }
__device__ __forceinline__ unsigned xb_add(unsigned* p, unsigned v) { return __hip_atomic_fetch_add(p, v, __ATOMIC_RELAXED, __HIP_MEMORY_SCOPE_AGENT); }
__device__ __forceinline__ unsigned xb_xcc_id() { return (unsigned)__builtin_amdgcn_s_getreg((3 << 11) | 20) & 0xFu; }
#define XB_SPIN(cond, bar) do { unsigned _sp = 0; while (cond) { __builtin_amdgcn_s_sleep(1); \
    if ((++_sp & 255u) == 0u) { if (xb_ld(&(bar)[XB_TMO])) break; if (_sp > XB_SPIN_CAP) { atomicAdd(&(bar)[XB_TMO], 1u); break; } } } } while (0)

struct XcdBarrier {
    unsigned* bar; unsigned x;
    volatile LAS unsigned* st;
};

__device__ __forceinline__ XcdBarrier xcd_barrier_post(unsigned* bar, volatile LAS unsigned* st) {
    XcdBarrier b; b.bar = bar; b.x = xb_xcc_id(); b.st = st;
    if (threadIdx.x == 0) (void)xb_add(&bar[XB_XCNT(b.x)], 1u);
    return b;
}
__device__ __forceinline__ void xcd_barrier_complete(unsigned* bar, unsigned x, unsigned& nloc, unsigned& nx) {
    const unsigned G = gridDim.x * gridDim.y * gridDim.z;
    unsigned sum, cnt, mine, sp = 0u;
    for (;;) {
        sum = 0u; cnt = 0u; mine = 0u;
#pragma unroll
        for (unsigned j = 0; j < 16; ++j) { const unsigned c = xb_ld(&bar[XB_XCNT(j)]); sum += c; cnt += (c > 0u) ? 1u : 0u; mine = (j == x) ? c : mine; }
        if (sum == G) break;
        __builtin_amdgcn_s_sleep(1);
        if ((++sp & 255u) == 0u) { if (xb_ld(&bar[XB_TMO])) break; if (sp > XB_SPIN_CAP) { atomicAdd(&bar[XB_TMO], 1u); break; } }
    }
    nloc = mine > 0u ? mine : 1u; nx = cnt > 0u ? cnt : 1u;
}

__device__ __forceinline__ void xcd_barrier(const XcdBarrier& b) {
    asm volatile("s_waitcnt vmcnt(0)" ::: "memory");
    __syncthreads();
    if (threadIdx.x == 0) {
        unsigned* bar = b.bar;
        __builtin_amdgcn_s_waitcnt(0);
        unsigned nloc = b.st[0], nx = b.st[1];
        if (nloc == 0u) { xcd_barrier_complete(bar, b.x, nloc, nx); b.st[0] = nloc; b.st[1] = nx; }
        const unsigned old = xb_add(&bar[XB_XSUB(b.x)], 1u);
        const unsigned gen = old / nloc;
        if (old + 1u == (gen + 1u) * nloc) {
            __builtin_amdgcn_fence(__ATOMIC_RELEASE, "agent");
            asm volatile("s_waitcnt vmcnt(0)" ::: "memory");
            const unsigned og = xb_add(&bar[XB_TOP], 1u);
            const unsigned tg = og / nx;
            if (og + 1u == (tg + 1u) * nx) xb_add(&bar[XB_TOPGEN], 1u);
            else XB_SPIN(xb_ld(&bar[XB_TOPGEN]) == tg, bar);
            __builtin_amdgcn_fence(__ATOMIC_ACQUIRE, "agent");
            xb_add(&bar[XB_XGEN(b.x)], 1u);
            asm volatile("s_waitcnt vmcnt(0)" ::: "memory");
        } else {
            XB_SPIN(xb_ld(&bar[XB_XGEN(b.x)]) == gen, bar);
            __builtin_amdgcn_fence(__ATOMIC_ACQUIRE, "agent");
            asm volatile("s_waitcnt vmcnt(0)" ::: "memory");
        }
    }
    __syncthreads();
}

__global__ void __launch_bounds__(512, 2) fwd(Args a) {
    extern __shared__ __attribute__((aligned(16))) unsigned char lds_raw[];
    cg::grid_group grid = cg::this_grid();
    LAS unsigned char* lds = (LAS unsigned char*)lds_raw;
#define PHASE_IDS size_t wz_ = 0; asm volatile("" : "+s"(wz_)); unsigned char* ws = a.ws + wz_; int tid_ = threadIdx.x; asm volatile("" : "+v"(tid_)); const int tid = tid_, lane = tid & 63, wave = __builtin_amdgcn_readfirstlane(tid >> 6), G = gridDim.x, bx = blockIdx.x; \
    const int gw = bx * 8 + wave, NGW = G * 8, gtid = bx * 512 + tid, NGT = G * 512; (void)lane; (void)gw; (void)NGW; (void)gtid; (void)NGT;
    unsigned char* ws = a.ws;
#define WinT ((bf16*)(ws + WS_WIN))
#define WoutT ((bf16*)(ws + WS_WOUT))
#define WupT ((bf16*)(ws + WS_WUP))
#define WdnT ((bf16*)(ws + WS_WDOWN))
#define WuqT ((bf16*)(ws + WS_WUQ))
#define WukvT ((bf16*)(ws + WS_WUKV))
#define H ((bf16*)(ws + WS_H))
#define Z ((bf16*)(ws + WS_Z))
#define QB ((bf16*)(ws + WS_QB))
#define KVB ((bf16*)(ws + WS_KVB))
#define MIX ((bf16*)(ws + WS_MIX))
#define Y ((float*)(ws + WS_Y))
#define U ((bf16*)(ws + WS_U))
#define Gb ((bf16*)(ws + WS_G))
#define R ((float*)(ws + WS_R))
#define tabF ((const f32x2*)(ws + WS_TABF))
#define tabM ((const f32x2*)(ws + WS_TABM))
#define x0 (a.in[0])
#define out (a.out)


    volatile LAS unsigned* MISC = (volatile LAS unsigned*)(lds + 131072 + 320);
    unsigned* barw = (unsigned*)(ws + WS_BAR);
    { const int t0_ = threadIdx.x; if (t0_ < 32) MISC[t0_] = 0u; if (blockIdx.x == 0) for (int i = t0_; i < XCD_BAR_WORDS; i += 512) barw[i] = 0u; }
    __syncthreads();
    { PHASE_IDS
    convert_weights(a, 0, ws, lds, gw, NGW, wave, lane, gtid, NGT);
#ifndef NO_TAB
    build_tables(ws, gtid, NGT);
#endif
    for (int t = gw; t < NT; t += NGW) norm_row_to_bf16(x0 + (size_t)t * DM, a.in[1], H + (size_t)t * DM, lane);
    }
    grid.sync();
    (void)xcd_barrier_post(barw, MISC + 8);
#define GRID_BAR() do { XcdBarrier bar_; bar_.bar = (unsigned*)(a.ws + WS_BAR); bar_.x = xb_xcc_id(); bar_.st = (volatile LAS unsigned*)((LAS unsigned char*)lds_raw + 131072 + 320) + 8; xcd_barrier(bar_); } while (0)

#pragma unroll 1
    for (int l = 0; l < 2; ++l) {
#ifdef PROBE_SYNC
        for (int rep = 0; rep < 20; ++rep) GRID_BAR();
#endif
        { size_t wz_ = 0; asm volatile("" : "+s"(wz_)); unsigned char* ws = a.ws + wz_; const int G = gridDim.x, bx = blockIdx.x; pg8::Gemm g{H, WinT, NT, ZP, DM, DM, DM}; pg8::StaticOrder S; S.init(NT, ZP, G, bx);
          pg8::EpiBf16<0> E{Z, ZP, nullptr, 0, 0, 1.f};
#ifdef PROBE_GEMM2
          for (int rep_ = 0; rep_ < 2; ++rep_)
#endif
          pg8::gemm_phase<pg8::EpiBf16<0>, pg8::StaticOrder, true, true>(lds, g, S, E); }
        GRID_BAR();
#ifndef NO_FIX
        { PHASE_IDS
        for (int t = gw; t < NT; t += NGW) fixup_row(Z + (size_t)t * ZP, t & (SEQ - 1), tabF, tabM, a.in[8] + l * 64, a.in[9] + l * 64, R + (size_t)t * 2, lane); }
#endif
        GRID_BAR();
        { size_t wz_ = 0; asm volatile("" : "+s"(wz_)); unsigned char* ws = a.ws + wz_; const int G = gridDim.x, bx = blockIdx.x; pg8::Gemm g{Z + ZB_CQ, WuqT, NT, 512, 256, ZP, 256}; pg8::StaticOrder S; S.init(NT, 512, G, bx);
          pg8::EpiBf16Row E{QB, QP, R, 0};
#ifdef PROBE_GEMM2
          for (int rep_ = 0; rep_ < 2; ++rep_)
#endif
          pg8::gemm_phase<pg8::EpiBf16Row, pg8::StaticOrder, true, true>(lds, g, S, E); }
        { size_t wz_ = 0; asm volatile("" : "+s"(wz_)); unsigned char* ws = a.ws + wz_; const int G = gridDim.x, bx = blockIdx.x; pg8::Gemm g{Z + ZB_CKV, WukvT, NT, 512, 128, ZP, 128}; pg8::StaticOrder S; S.init(NT, 512, G, (bx + G / 2) % G);
          pg8::EpiBf16Row E{KVB, QP, R, 1};
#ifdef PROBE_GEMM2
          for (int rep_ = 0; rep_ < 2; ++rep_)
#endif
          pg8::gemm_phase<pg8::EpiBf16Row, pg8::StaticOrder, true, true>(lds, g, S, E); }
        GRID_BAR();
#ifndef NO_ATTN
        { PHASE_IDS
        const float* rpb = a.in[3] + (size_t)l * 4 * 465; const float* sink = a.in[10] + l * 4;
        for (int u = bx; u < 1024; u += G) {
            const int kind = u >> 8, v = u & 255, bh = v & 7, b = bh >> 2, head = bh & 3, qblk = v >> 3;
#ifdef PROBE_KIND
            for (int rep = 0; rep < ((kind == PROBE_KIND) ? 2 : 1); ++rep)
#endif
            if (kind == 0) fa_dense_sp<1>(Z, QB, KVB, MIX, tabM, b, head, qblk, lds, tid);
            else if (kind == 1) fa_dense_sp<2>(Z, QB, KVB, MIX, tabM, b, head, qblk, lds, tid);
            else if (kind == 2) fa_unit<0>(Z, QB, KVB, MIX, tabM, rpb, sink, b, head, qblk, lds, tid);
            else fa_unit<3>(Z, QB, KVB, MIX, tabM, rpb, sink, b, head, qblk, lds, tid);
            __syncthreads();
        } }
#endif
        GRID_BAR();
        { size_t wz_ = 0; asm volatile("" : "+s"(wz_)); unsigned char* ws = a.ws + wz_; const int G = gridDim.x, bx = blockIdx.x; pg8::Gemm g{MIX, WoutT, NT, DM, DM, DM, DM}; pg8::StaticOrder S; S.init(NT, DM, G, bx);
          pg8::EpiF32 E{Y, DM};
#ifdef PROBE_GEMM2
          for (int rep_ = 0; rep_ < 2; ++rep_)
#endif
          pg8::gemm_phase<pg8::EpiF32, pg8::StaticOrder, true, true>(lds, g, S, E); }
        GRID_BAR();
        { PHASE_IDS const float* xin = (l == 0) ? x0 : out;
          for (int t = gw; t < NT; t += NGW) resnorm_row(Y + (size_t)t * DM, xin + (size_t)t * DM, a.in[12] + l * DM, out + (size_t)t * DM, a.in[13] + l * DM, H + (size_t)t * DM, lane); }
        GRID_BAR();
#pragma unroll 1
        for (int hb = 0; hb < 2; ++hb) {
            { size_t wz_ = 0; asm volatile("" : "+s"(wz_)); unsigned char* ws = a.ws + wz_; const int G = gridDim.x, bx = blockIdx.x; pg8::Gemm g{H + (size_t)hb * SEQ * DM, WupT, SEQ, FF2, DM, DM, DM}; pg8::StaticOrder S; S.init(SEQ, FF2, G, bx);
              pg8::EpiBf16<0> E{U, FF2, nullptr, 0, 0, 1.f};
#ifdef PROBE_GEMM2
          for (int rep_ = 0; rep_ < 2; ++rep_)
#endif
              pg8::gemm_phase<pg8::EpiBf16<0>, pg8::StaticOrder, true, true>(lds, g, S, E); }
            GRID_BAR();
#ifndef NO_CONV
#ifdef PROBE_CONV2
            for (int rep_ = 0; rep_ < 2; ++rep_)
#endif
            { PHASE_IDS conv_phase(U, Gb + (size_t)hb * SEQ * FF, a.in[15] + (size_t)l * 3 * FF2, a.in[16] + (size_t)l * FF2, gtid, NGT); }
#endif
            GRID_BAR();
        }
        { size_t wz_ = 0; asm volatile("" : "+s"(wz_)); unsigned char* ws = a.ws + wz_; const int G = gridDim.x, bx = blockIdx.x; pg8::Gemm g{Gb, WdnT, NT, DM, FF, FF, FF}; pg8::StaticOrder S; S.init(NT, DM, G, bx);
          pg8::EpiF32 E{Y, DM};
#ifdef PROBE_GEMM2
          for (int rep_ = 0; rep_ < 2; ++rep_)
#endif
          pg8::gemm_phase<pg8::EpiF32, pg8::StaticOrder, true, true>(lds, g, S, E); }
        GRID_BAR();
        { PHASE_IDS
        for (int t = gw; t < NT; t += NGW) resnorm_row(Y + (size_t)t * DM, out + (size_t)t * DM, a.in[18] + l * DM, out + (size_t)t * DM, a.in[1] + DM, (l == 0) ? H + (size_t)t * DM : nullptr, lane);
        if (l == 0) { convert_weights(a, 1, ws, lds, gw, NGW, wave, lane, gtid, NGT); } }
        if (l == 0) GRID_BAR();
    }
}

#undef WinT
#undef WoutT
#undef WupT
#undef WdnT
#undef WuqT
#undef WukvT
#undef H
#undef Z
#undef QB
#undef KVB
#undef MIX
#undef Y
#undef U
#undef Gb
#undef R
#undef tabF
#undef tabM
#undef x0
#undef out
extern "C" void kernel_launch(void* const* d_in, const int* in_sizes, int n_in, void* d_out, int out_size, void* d_ws, size_t ws_size, hipStream_t stream) {
    static int grid = 0;
    if (grid == 0) {
        int dev = 0, cus = 0, per_cu = 0;
        hipGetDevice(&dev); hipDeviceGetAttribute(&cus, hipDeviceAttributeMultiprocessorCount, dev);
        hipFuncSetAttribute((const void*)fwd, hipFuncAttributeMaxDynamicSharedMemorySize, LDS_BYTES);
        hipOccupancyMaxActiveBlocksPerMultiprocessor(&per_cu, (const void*)fwd, 512, LDS_BYTES);
        if (per_cu < 1) { fprintf(stderr, "occupancy query says %d blocks/CU\n", per_cu); per_cu = 1; }
        grid = cus;
        if (ws_size < WS_END) { fprintf(stderr, "workspace too small: %zu < %zu\n", ws_size, (size_t)WS_END); grid = -1; }
    }
    if (grid < 0) return;
    Args a{};
    for (int i = 0; i < 19; ++i) a.in[i] = (const float*)d_in[i];
    a.out = (float*)d_out; a.ws = (unsigned char*)d_ws;
    void* args[] = {&a};
    hipError_t e = hipLaunchCooperativeKernel((const void*)fwd, dim3(grid), dim3(512), args, LDS_BYTES, stream);
    if (e != hipSuccess) fprintf(stderr, "cooperative launch failed: %s (grid %d)\n", hipGetErrorString(e), grid);
}
```
